# Optimizing an MI355X kernel written in HIP

```python
import math
import jax
import jax.numpy as jnp
from jax import lax
import numpy as np

D_MODEL = 1024
BATCH = 4
SEQ = 8192
DEPTH = 2

GRID_W = 64
CTX_LEN = 256
N_MOD = 6
D_S5 = D_MODEL // 2
S5_GROUP = 16
S5_GROUPS = D_S5 // S5_GROUP
S5_STATE = 64
DT_MIN = 0.001
DT_MAX = 0.1
GLA_HEADS = 4
GLA_VAL = D_MODEL // 2
GLA_KEY = GLA_VAL // 2
GLA_DK = GLA_KEY // GLA_HEADS
GLA_DV = GLA_VAL // GLA_HEADS
GLA_GATE_RANK = 16
GLA_TAU = 16.0
GLA_CHUNK = 64
N_GROUPS = 4
EXPERTS_PER_GROUP = 4
N_EXPERTS = N_GROUPS * EXPERTS_PER_GROUP
EXPERT_TOP_K = 2
D_EXPERT = D_MODEL // 2
NORM_EPS = 1e-6

kernel_name = 'hybrid_s5_gla_hmoe_prefix_dit'


def rmsnorm(x, g):
    xf = x.astype(jnp.float32)
    y = xf * lax.rsqrt(jnp.mean(xf * xf, axis=-1, keepdims=True) + NORM_EPS)
    return (y * g.astype(jnp.float32)).astype(x.dtype)


def modulate(h, shift, scale):
    return h * (1 + scale) + shift


def raster_to_column(t, rows):
    b, rest = t.shape[0], t.shape[2:]
    return t.reshape((b, rows, GRID_W) + rest).swapaxes(1, 2).reshape((b, rows * GRID_W) + rest)


def column_to_raster(t, rows):
    b, rest = t.shape[0], t.shape[2:]
    return t.reshape((b, GRID_W, rows) + rest).swapaxes(1, 2).reshape((b, rows * GRID_W) + rest)


def s5_discretize(lam_re, lam_im, log_dt, b_re, b_im):
    dt = jnp.exp(log_dt)[:, None]
    mag = jnp.exp(lam_re * dt)
    ab_re = mag * jnp.cos(lam_im * dt)
    ab_im = mag * jnp.sin(lam_im * dt)
    den = lam_re * lam_re + lam_im * lam_im
    k_re = ((ab_re - 1) * lam_re + ab_im * lam_im) / den
    k_im = (ab_im * lam_re - (ab_re - 1) * lam_im) / den
    bb_re = k_re[..., None] * b_re - k_im[..., None] * b_im
    bb_im = k_re[..., None] * b_im + k_im[..., None] * b_re
    return ab_re, ab_im, bb_re, bb_im


def complex_affine_combine(e1, e2):
    a1r, a1i, b1r, b1i = e1
    a2r, a2i, b2r, b2i = e2
    return (a2r * a1r - a2i * a1i,
            a2r * a1i + a2i * a1r,
            a2r * b1r - a2i * b1i + b2r,
            a2r * b1i + a2i * b1r + b2i)


def s5_states(u, lp, d, h0, reverse):
    f32 = jnp.float32
    ab_re, ab_im, bb_re, bb_im = s5_discretize(
        lp['s5_lam_re'][d].astype(f32), lp['s5_lam_im'][d].astype(f32),
        lp['s5_log_dt'][d].astype(f32), lp['s5_b_re'][d].astype(f32), lp['s5_b_im'][d].astype(f32))
    h0_re, h0_im = h0
    bu_re = jnp.einsum('blgh,gph->blgp', u, bb_re)
    bu_im = jnp.einsum('blgh,gph->blgp', u, bb_im)
    first = -1 if reverse else 0
    bu_re = bu_re.at[:, first].add(ab_re * h0_re - ab_im * h0_im)
    bu_im = bu_im.at[:, first].add(ab_re * h0_im + ab_im * h0_re)
    n = u.shape[1]
    a_re = jnp.broadcast_to(ab_re, (1, n) + ab_re.shape)
    a_im = jnp.broadcast_to(ab_im, (1, n) + ab_im.shape)
    _, _, s_re, s_im = lax.associative_scan(
        complex_affine_combine, (a_re, a_im, bu_re, bu_im), reverse=reverse, axis=1)
    return s_re, s_im


def s5_readout(s_re, s_im, lp, d):
    c_re = lp['s5_c_re'][d].astype(jnp.float32)
    c_im = lp['s5_c_im'][d].astype(jnp.float32)
    return jnp.einsum('blgp,ghp->blgh', s_re, c_re) - jnp.einsum('blgp,ghp->blgh', s_im, c_im)


def gla_log_forget(h, lp, d):
    bsz, n, _ = h.shape
    z = (h @ lp['gla_w_gate1'][d]) @ lp['gla_w_gate2'][d] + lp['gla_b_gate'][d]
    return (jax.nn.log_sigmoid(z.astype(jnp.float32)) / GLA_TAU).reshape(bsz, n, GLA_HEADS, GLA_DK)


def gla_chunked(q, k, v, log_a, s0, with_output):
    bsz, n_tok, nh, _ = q.shape
    dv = v.shape[-1]
    nc = n_tok // GLA_CHUNK

    def blocks(t):
        return t.reshape(bsz, nc, GLA_CHUNK, nh, t.shape[-1])

    q, k, v, log_a = blocks(q), blocks(k), blocks(v), blocks(log_a)
    b = jnp.cumsum(log_a, axis=2)
    b_end = b[:, :, -1]
    chunk_kv = jnp.einsum('bnshk,bnshv->bnhkv', k * jnp.exp(b_end[:, :, None] - b), v)
    decay = jnp.exp(b_end)

    def step(s, inp):
        dcy, kv = inp
        return dcy[..., None] * s + kv, s

    s_final, s_start = lax.scan(step, s0, (jnp.moveaxis(decay, 1, 0), jnp.moveaxis(chunk_kv, 1, 0)))
    if not with_output:
        return None, s_final
    s_start = jnp.moveaxis(s_start, 0, 1)
    q_dec = q * jnp.exp(b)
    k_inv = k * jnp.exp(-b)
    scores = jnp.einsum('bnthk,bnshk->bnhts', q_dec, k_inv)
    lower = jnp.tril(jnp.ones((GLA_CHUNK, GLA_CHUNK), dtype=bool))
    scores = jnp.where(lower, scores, 0.0)
    o = (jnp.einsum('bnhts,bnshv->bnthv', scores, v)
         + jnp.einsum('bnthk,bnhkv->bnthv', q_dec, s_start))
    return o.reshape(bsz, n_tok, nh, dv), s_final


def token_mixer(h, lp, init, rows, with_output):
    f32 = jnp.float32
    bsz, n, _ = h.shape
    sizes = (D_S5, GLA_KEY, GLA_KEY, GLA_VAL, GLA_VAL, D_MODEL)
    cuts = [int(s) for s in np.cumsum(sizes)]
    u, q, k, v, r, gate_s5, gate_gla = jnp.split(h @ lp['w_in'], cuts, axis=-1)
    if init is None:
        zs = jnp.zeros((bsz, S5_GROUPS, S5_STATE), f32)
        zg = jnp.zeros((bsz, GLA_HEADS, GLA_DK, GLA_DV), f32)
        init = ((zs, zs), (zs, zs), zg, zg)
    h5f, h5b, sgf, sgb = init

    uf = u.astype(f32)
    ug = uf.reshape(bsz, n, S5_GROUPS, S5_GROUP)
    sf_re, sf_im = s5_states(ug, lp, 0, h5f, reverse=False)
    sb_re, sb_im = s5_states(ug, lp, 1, h5b, reverse=True)

    qh = q.astype(f32).reshape(bsz, n, GLA_HEADS, GLA_DK) * (GLA_DK ** -0.5)
    kh = k.astype(f32).reshape(bsz, n, GLA_HEADS, GLA_DK)
    vh = v.astype(f32).reshape(bsz, n, GLA_HEADS, GLA_DV)
    la_f = gla_log_forget(h, lp, 0)
    la_b = gla_log_forget(h, lp, 1)
    if rows is not None:
        qh, kh, vh, la_f, la_b = [raster_to_column(t, rows) for t in (qh, kh, vh, la_f, la_b)]
    o_f, sgf_end = gla_chunked(qh, kh, vh, la_f, sgf, with_output)
    o_b, sgb_end = gla_chunked(jnp.flip(qh, 1), jnp.flip(kh, 1), jnp.flip(vh, 1),
                               jnp.flip(la_b, 1), sgb, with_output)
    final = ((sf_re[:, -1], sf_im[:, -1]), (sb_re[:, 0], sb_im[:, 0]), sgf_end, sgb_end)
    if not with_output:
        return None, final

    y = (s5_readout(sf_re, sf_im, lp, 0) + s5_readout(sb_re, sb_im, lp, 1)).reshape(bsz, n, D_S5)
    y = y + lp['s5_d'].astype(f32) * uf
    a = jax.nn.gelu(y).astype(h.dtype)
    y_s5 = (a @ lp['w_glu_a']) * jax.nn.sigmoid(a @ lp['w_glu_b'])

    o = o_f + jnp.flip(o_b, 1)
    if rows is not None:
        o = column_to_raster(o, rows)
    o = o * lax.rsqrt(jnp.mean(o * o, axis=-1, keepdims=True) + NORM_EPS) * lp['gla_norm_g'].astype(f32)
    o = o.reshape(bsz, n, GLA_VAL).astype(h.dtype) * jax.nn.silu(r)
    y_gla = o @ lp['w_gla_up']

    merged = jax.nn.sigmoid(gate_s5) * y_s5 + jax.nn.sigmoid(gate_gla) * y_gla
    return merged @ lp['w_out'], final


def hier_moe(h, lp):
    f32 = jnp.float32
    shape = h.shape
    t = h.reshape(-1, D_MODEL)
    g_prob = jax.nn.softmax((t @ lp['w_route_group'] + lp['b_route_group']).astype(f32), axis=-1)
    p_grp, grp = lax.top_k(g_prob, 1)
    e_logits = (jnp.einsum('td,gde->tge', t, lp['w_route_expert']) + lp['b_route_expert']).astype(f32)
    e_sel = jnp.einsum('tge,tg->te', e_logits, jax.nn.one_hot(grp[:, 0], N_GROUPS, dtype=f32))
    v2, i2 = lax.top_k(e_sel, EXPERT_TOP_K)
    w = jax.nn.softmax(v2, axis=-1) * p_grp
    eid = grp * EXPERTS_PER_GROUP + i2
    combine = jnp.sum(jax.nn.one_hot(eid, N_EXPERTS, dtype=f32) * w[..., None], axis=1).astype(t.dtype)
    y = jnp.zeros_like(t)
    for e in range(N_EXPERTS):
        hid = jax.nn.silu(t @ lp['w_exp_gate'][e]) * (t @ lp['w_exp_up'][e])
        y = y + combine[:, e:e + 1] * (hid @ lp['w_exp_down'][e])
    return y.reshape(shape)


def setup_inputs(seed: int = 0) -> dict:
    key = jax.random.key(seed)
    ks = iter(jax.random.split(key, 40))
    f32 = jnp.float32
    D, G, P, H = D_MODEL, S5_GROUPS, S5_STATE, S5_GROUP

    def nrm(shape, scale):
        return jax.random.normal(next(ks), shape, f32) * scale

    lam_im_base = jnp.pi * jnp.arange(P, dtype=f32)
    return {
        'x': nrm((BATCH, SEQ, D), 1.0),
        'c': nrm((BATCH, D), 1.0),
        'ctx': nrm((BATCH, CTX_LEN, D), 1.0),
        'c_ctx': nrm((D,), 1.0),
        'w_mod': nrm((DEPTH, D, N_MOD * D), 0.5 * D ** -0.5),
        'b_mod': nrm((DEPTH, N_MOD * D), 0.02),
        'norm1_g': 1.0 + nrm((DEPTH, D), 0.02),
        'norm2_g': 1.0 + nrm((DEPTH, D), 0.02),
        'w_in': nrm((DEPTH, D, D_S5 + 2 * GLA_KEY + 2 * GLA_VAL + 2 * D), D ** -0.5),
        's5_lam_re': -0.5 + nrm((DEPTH, 2, G, P), 0.01),
        's5_lam_im': lam_im_base + nrm((DEPTH, 2, G, P), 0.01),
        's5_log_dt': jax.random.uniform(next(ks), (DEPTH, 2, G), f32, math.log(DT_MIN), math.log(DT_MAX)),
        's5_b_re': nrm((DEPTH, 2, G, P, H), (2 * H) ** -0.5),
        's5_b_im': nrm((DEPTH, 2, G, P, H), (2 * H) ** -0.5),
        's5_c_re': nrm((DEPTH, 2, G, H, P), 0.5),
        's5_c_im': nrm((DEPTH, 2, G, H, P), 0.5),
        's5_d': nrm((DEPTH, D_S5), 1.0),
        'w_glu_a': nrm((DEPTH, D_S5, D), D_S5 ** -0.5),
        'w_glu_b': nrm((DEPTH, D_S5, D), D_S5 ** -0.5),
        'gla_w_gate1': nrm((DEPTH, 2, D, GLA_GATE_RANK), D ** -0.5),
        'gla_w_gate2': nrm((DEPTH, 2, GLA_GATE_RANK, GLA_KEY), GLA_GATE_RANK ** -0.5),
        'gla_b_gate': nrm((DEPTH, 2, GLA_KEY), 0.1),
        'gla_norm_g': 1.0 + nrm((DEPTH, GLA_DV), 0.02),
        'w_gla_up': nrm((DEPTH, GLA_VAL, D), GLA_VAL ** -0.5),
        'w_out': nrm((DEPTH, D, D), D ** -0.5),
        'w_route_group': nrm((DEPTH, D, N_GROUPS), D ** -0.5),
        'b_route_group': nrm((DEPTH, N_GROUPS), 0.01),
        'w_route_expert': nrm((DEPTH, N_GROUPS, D, EXPERTS_PER_GROUP), D ** -0.5),
        'b_route_expert': nrm((DEPTH, N_GROUPS, EXPERTS_PER_GROUP), 0.01),
        'w_exp_gate': nrm((DEPTH, N_EXPERTS, D, D_EXPERT), D ** -0.5),
        'w_exp_up': nrm((DEPTH, N_EXPERTS, D, D_EXPERT), D ** -0.5),
        'w_exp_down': nrm((DEPTH, N_EXPERTS, D_EXPERT, D), D_EXPERT ** -0.5),
        'final_g': 1.0 + nrm((D,), 0.02),
    }


def reference(x, c, ctx, c_ctx, w_mod, b_mod, norm1_g, norm2_g, w_in, s5_lam_re, s5_lam_im,
              s5_log_dt, s5_b_re, s5_b_im, s5_c_re, s5_c_im, s5_d, w_glu_a, w_glu_b,
              gla_w_gate1, gla_w_gate2, gla_b_gate, gla_norm_g, w_gla_up, w_out,
              w_route_group, b_route_group, w_route_expert, b_route_expert,
              w_exp_gate, w_exp_up, w_exp_down, final_g):
    rows = x.shape[1] // GRID_W
    lat, cst = x, ctx
    for l in range(DEPTH):
        lp = {
            'w_in': w_in[l], 's5_lam_re': s5_lam_re[l], 's5_lam_im': s5_lam_im[l],
            's5_log_dt': s5_log_dt[l], 's5_b_re': s5_b_re[l], 's5_b_im': s5_b_im[l],
            's5_c_re': s5_c_re[l], 's5_c_im': s5_c_im[l], 's5_d': s5_d[l],
            'w_glu_a': w_glu_a[l], 'w_glu_b': w_glu_b[l],
            'gla_w_gate1': gla_w_gate1[l], 'gla_w_gate2': gla_w_gate2[l], 'gla_b_gate': gla_b_gate[l],
            'gla_norm_g': gla_norm_g[l], 'w_gla_up': w_gla_up[l], 'w_out': w_out[l],
            'w_route_group': w_route_group[l], 'b_route_group': b_route_group[l],
            'w_route_expert': w_route_expert[l], 'b_route_expert': b_route_expert[l],
            'w_exp_gate': w_exp_gate[l], 'w_exp_up': w_exp_up[l], 'w_exp_down': w_exp_down[l],
        }
        last = l == DEPTH - 1
        sh1, sc1, g1, sh2, sc2, g2 = jnp.split(
            (jax.nn.silu(c) @ w_mod[l] + b_mod[l])[:, None, :], N_MOD, axis=-1)
        csh1, csc1, cg1, csh2, csc2, cg2 = jnp.split(
            jax.nn.silu(c_ctx) @ w_mod[l] + b_mod[l], N_MOD, axis=-1)

        hc = modulate(rmsnorm(cst, norm1_g[l]), csh1, csc1)
        ctx_mix, ctx_states = token_mixer(hc, lp, None, None, not last)
        hl = modulate(rmsnorm(lat, norm1_g[l]), sh1, sc1)
        lat_mix, _ = token_mixer(hl, lp, ctx_states, rows, True)
        lat = lat + g1 * lat_mix

        hl2 = modulate(rmsnorm(lat, norm2_g[l]), sh2, sc2)
        if last:
            lat = lat + g2 * hier_moe(hl2, lp)
        else:
            cst = cst + cg1 * ctx_mix
            hc2 = modulate(rmsnorm(cst, norm2_g[l]), csh2, csc2)
            n_ctx = cst.shape[1]
            ffn = hier_moe(jnp.concatenate([hc2, hl2], axis=1), lp)
            cst = cst + cg2 * ffn[:, :n_ctx]
            lat = lat + g2 * ffn[:, n_ctx:]
    return rmsnorm(lat, final_g)
```

```cpp
#include <hip/hip_runtime.h>
#include <cstdio>
#include <cstdint>

#define G8_ORIGMAP 0
#define DBG_CHECK 0
#ifndef FAST_MASK
#define FAST_MASK 0xff
#endif
#ifndef MK_ONE_LAUNCH
#define MK_ONE_LAUNCH 1
#endif

namespace {

typedef unsigned short bf16;
typedef short bf16x8 __attribute__((ext_vector_type(8)));
typedef float f32x4 __attribute__((ext_vector_type(4)));
#define LAS __attribute__((address_space(3)))

constexpr int D = 1024, NB_ = 4, SEQ = 8192, CTXL = 256;
constexpr int NLAT = NB_ * SEQ;
constexpr int NCTX = NB_ * CTXL;
constexpr int MTOT = NLAT + NCTX;
constexpr int NTHR = 512;
constexpr int LDS_BYTES = 147456;
constexpr int NPHASE = 24;
constexpr int NWIN = 2304;
constexpr int BRP = 2304;
constexpr int NBR = 2112;
constexpr int NPC = 66;
constexpr int CAP = MTOT;
constexpr int TM = 128;

constexpr int PQ = 0, PK = 256, PV = 512, PR = 1024, PZF = 1536, PZB = 1792;

constexpr size_t al256(size_t x) { return (x + 255) & ~(size_t)255; }
constexpr size_t WS_CTL = 0;
constexpr size_t CTL_BYTES = 65536;
constexpr size_t CTL_CNT_OFF = 16384;
constexpr size_t CTL_TILE_OFF = 20480;
constexpr int TILE_CAP = 160, TILE_STRIDE = 32;
static_assert(CTL_TILE_OFF + (size_t)2 * TILE_CAP * TILE_STRIDE * 4 <= CTL_BYTES, "control block");
constexpr size_t WS_MODS = WS_CTL + CTL_BYTES;
constexpr size_t WS_S5AT = WS_MODS + al256(2 * 5 * 6144 * 4);
constexpr size_t WS_WIN = 1048576;
constexpr size_t WS_WG = WS_WIN + (size_t)NWIN * 1024 * 2;
constexpr size_t WS_WA = WS_WG + (size_t)2048 * 1024 * 2;
constexpr size_t WS_WB = WS_WA + (size_t)1024 * 512 * 2;
constexpr size_t WS_WUP = WS_WB + (size_t)1024 * 512 * 2;
constexpr size_t WS_WOUT = WS_WUP + (size_t)1024 * 512 * 2;
constexpr size_t WS_WEG = WS_WOUT + (size_t)1024 * 1024 * 2;
constexpr size_t WS_WEU = WS_WEG + (size_t)16 * 512 * 1024 * 2;
constexpr size_t WS_WED = WS_WEU + (size_t)16 * 512 * 1024 * 2;
constexpr size_t WS_WE = WS_WED + (size_t)16 * 512 * 1024 * 2;
constexpr size_t WS_WY = WS_WE + (size_t)32 * 256 * 256 * 2;
constexpr size_t WS_H = WS_WY + (size_t)32 * 256 * 512 * 2;
constexpr size_t WS_PROJ = WS_H + (size_t)MTOT * D * 2;
constexpr size_t WS_USB = WS_PROJ + (size_t)MTOT * 2048 * 2;
constexpr size_t WS_EB = WS_USB + (size_t)32 * BRP * 512 * 2;
constexpr size_t WS_KVB = WS_EB + (size_t)32 * BRP * 256 * 2;
constexpr size_t WS_AB = WS_EB;
constexpr size_t WS_OB = WS_AB + (size_t)MTOT * 512 * 2;
constexpr size_t WS_DEC = WS_KVB + (size_t)4 * 2 * NPC * 4 * 8192 * 2;
constexpr size_t WS_SST = WS_DEC + al256((size_t)4 * 2 * NPC * 4 * 64 * 4);
constexpr size_t WS_PERM = WS_SST + (size_t)4 * 2 * NPC * 4 * 8192 * 2;
constexpr size_t WS_PW = WS_PERM + (size_t)24 * CAP * 4;
constexpr size_t WS_T1 = WS_PW + (size_t)24 * CAP * 8;
constexpr size_t WS_SG5Q = WS_T1 + (size_t)MTOT * 32 * 2;
constexpr size_t WS_X1 = WS_SG5Q + (size_t)MTOT * 1024;
constexpr int X1_SPLIT = 29;
constexpr size_t X1_OUT_OFF = (size_t)MTOT * 2048 + (size_t)MTOT * 1024;
constexpr size_t WS_END = WS_X1 + (size_t)(48 - X1_SPLIT) * 1048576;
static_assert(X1_OUT_OFF + (size_t)X1_SPLIT * 1048576 <= (size_t)NLAT * D * 4, "d_out tail");
static_assert(WS_OB + (size_t)MTOT * 512 * 2 <= WS_DEC, "AB/OB alias region");
static_assert(WS_S5AT + 2 * 32 * 64 * 8 <= WS_WIN, "small region");
static_assert(WS_END <= (size_t)512 * 1024 * 1024, "workspace");

#define XB_TMO      128
#define XB_XCNT(j)  (256  + 64 * (j))
#define XB_XSUB(j)  (1280 + 64 * (j))
#define XB_XGEN(j)  (2304 + 64 * (j))
#define XB_TOP      3328
#define XB_TOPGEN   3392
#define XCD_BAR_WORDS 3456
#define XB_SPIN_CAP (1u << 18)

__device__ __forceinline__ unsigned xb_ld(unsigned* p)              { return __hip_atomic_load(p, __ATOMIC_RELAXED, __HIP_MEMORY_SCOPE_AGENT); }
__device__ __forceinline__ unsigned xb_add(unsigned* p, unsigned v) { return __hip_atomic_fetch_add(p, v, __ATOMIC_RELAXED, __HIP_MEMORY_SCOPE_AGENT); }
__device__ __forceinline__ unsigned xb_xcc_id() { return (unsigned)__builtin_amdgcn_s_getreg((3 << 11) | 20) & 0xFu; }
#define XB_SPIN(cond, bar) do { unsigned _sp = 0; while (cond) { __builtin_amdgcn_s_sleep(1); \
    if ((++_sp & 255u) == 0u) { if (xb_ld(&(bar)[XB_TMO])) break; if (_sp > XB_SPIN_CAP) { atomicAdd(&(bar)[XB_TMO], 1u); break; } } } } while (0)

struct XcdBarrier { unsigned* bar; unsigned x; volatile LAS unsigned* st; };

__device__ __forceinline__ XcdBarrier xcd_barrier_post(unsigned* bar, volatile LAS unsigned* st) {
    XcdBarrier b; b.bar = bar; b.x = xb_xcc_id(); b.st = st;
    if (threadIdx.x == 0) (void)xb_add(&bar[XB_XCNT(b.x)], 1u);
    return b;
}
__device__ __forceinline__ void xcd_barrier_complete(unsigned* bar, unsigned x, unsigned& nloc, unsigned& nx) {
    const unsigned G = gridDim.x * gridDim.y * gridDim.z;
    unsigned sum, cnt, mine, sp = 0u;
    for (;;) {
        sum = 0u; cnt = 0u; mine = 0u;
#pragma unroll
        for (unsigned j = 0; j < 16; ++j) { const unsigned c = xb_ld(&bar[XB_XCNT(j)]); sum += c; cnt += (c > 0u) ? 1u : 0u; mine = (j == x) ? c : mine; }
        if (sum == G) break;
        __builtin_amdgcn_s_sleep(1);
        if ((++sp & 255u) == 0u) { if (xb_ld(&bar[XB_TMO])) break; if (sp > XB_SPIN_CAP) { atomicAdd(&bar[XB_TMO], 1u); break; } }
    }
    nloc = mine > 0u ? mine : 1u; nx = cnt > 0u ? cnt : 1u;
}
__device__ __forceinline__ void xcd_barrier(const XcdBarrier& b) {
    asm volatile("s_waitcnt vmcnt(0)" ::: "memory");
    __syncthreads();
    if (threadIdx.x == 0) {
        unsigned* bar = b.bar;
        __builtin_amdgcn_s_waitcnt(0);
        unsigned nloc = b.st[0], nx = b.st[1];
        if (nloc == 0u) { xcd_barrier_complete(bar, b.x, nloc, nx); b.st[0] = nloc; b.st[1] = nx; }
        const unsigned old = xb_add(&bar[XB_XSUB(b.x)], 1u);
        const unsigned gen = old / nloc;
        if (old + 1u == (gen + 1u) * nloc) {
            __builtin_amdgcn_fence(__ATOMIC_RELEASE, "agent");
            asm volatile("s_waitcnt vmcnt(0)" ::: "memory");
            const unsigned og = xb_add(&bar[XB_TOP], 1u);
            const unsigned tg = og / nx;
            if (og + 1u == (tg + 1u) * nx) xb_add(&bar[XB_TOPGEN], 1u);
            else XB_SPIN(xb_ld(&bar[XB_TOPGEN]) == tg, bar);
            __builtin_amdgcn_fence(__ATOMIC_ACQUIRE, "agent");
            xb_add(&bar[XB_XGEN(b.x)], 1u);
            asm volatile("s_waitcnt vmcnt(0)" ::: "memory");
        } else {
            XB_SPIN(xb_ld(&bar[XB_XGEN(b.x)]) == gen, bar);
            __builtin_amdgcn_fence(__ATOMIC_ACQUIRE, "agent");
            asm volatile("s_waitcnt vmcnt(0)" ::: "memory");
        }
    }
    __syncthreads();
}

typedef __bf16 bf16x2_t __attribute__((ext_vector_type(2)));
__device__ __forceinline__ unsigned cvt_pk_bf16(float lo, float hi) { bf16x2_t v; v[0] = (__bf16)lo; v[1] = (__bf16)hi; return __builtin_bit_cast(unsigned, v); }
__device__ __forceinline__ bf16 f2bf(float f) { return (bf16)(cvt_pk_bf16(f, 0.f) & 0xffffu); }
__device__ __forceinline__ float bf2f(bf16 b) { return __uint_as_float(((unsigned)b) << 16); }
__device__ __forceinline__ float bflo(unsigned w) { return __uint_as_float(w << 16); }
__device__ __forceinline__ float bfhi(unsigned w) { return __uint_as_float(w & 0xffff0000u); }
__device__ __forceinline__ float sigmoidf_(float x) { return __builtin_amdgcn_rcpf(1.0f + __expf(-x)); }
__device__ __forceinline__ float siluf_(float x) { return x * __builtin_amdgcn_rcpf(1.0f + __expf(-x)); }
__device__ __forceinline__ float gelu_tanh(float x) { const float u = 0.7978845608028654f * (x + 0.044715f * x * x * x); const float t = 1.0f - 2.0f * __builtin_amdgcn_rcpf(1.0f + __expf(2.0f * u)); return 0.5f * x * (1.0f + t); }
__device__ __forceinline__ float logsigmoidf_(float x) { return fminf(x, 0.f) - log1pf(__expf(-fabsf(x))); }
__device__ __forceinline__ float wave_sum(float v) {
    const int z = 0;
    v += __builtin_bit_cast(float, __builtin_amdgcn_update_dpp(z, __builtin_bit_cast(int, v), 0xB1, 0xf, 0xf, true));
    v += __builtin_bit_cast(float, __builtin_amdgcn_update_dpp(z, __builtin_bit_cast(int, v), 0x4E, 0xf, 0xf, true));
    v += __builtin_bit_cast(float, __builtin_amdgcn_update_dpp(z, __builtin_bit_cast(int, v), 0x141, 0xf, 0xf, true));
    v += __builtin_bit_cast(float, __builtin_amdgcn_update_dpp(z, __builtin_bit_cast(int, v), 0x140, 0xf, 0xf, true));
    v += __builtin_bit_cast(float, __builtin_amdgcn_update_dpp(z, __builtin_bit_cast(int, v), 0x142, 0xa, 0xf, false));
    v += __builtin_bit_cast(float, __builtin_amdgcn_update_dpp(z, __builtin_bit_cast(int, v), 0x143, 0xc, 0xf, false));
    return __builtin_bit_cast(float, __builtin_amdgcn_readlane(__builtin_bit_cast(int, v), 63));
}
__device__ __forceinline__ void store_bf16x4(bf16* p, f32x4 v) { uint2 w; w.x = cvt_pk_bf16(v[0], v[1]); w.y = cvt_pk_bf16(v[2], v[3]); *(uint2*)p = w; }


__device__ __forceinline__ double my_exp(double x) {
    unsigned long long z_ = 0; asm volatile("" : "+s"(z_));
    const double k = rint(x * __longlong_as_double(0x3FF71547652B82FEull ^ z_));
    const double r = (x - k * __longlong_as_double(0x3FE62E42FEE00000ull ^ z_)) - k * __longlong_as_double(0x3DEA39EF35793C76ull ^ z_);
    double t = 1.0, sum = 1.0;
#pragma unroll 1
    for (int i = 1; i <= 16; ++i) { t = t * r / (double)i; sum += t; }
    const long long bits = ((long long)k + 1023ll) << 52;
    return sum * __longlong_as_double(bits);
}
__device__ __forceinline__ void my_sincos(double x, double& s, double& c) {
    unsigned long long z_ = 0; asm volatile("" : "+s"(z_));
    const double k = rint(x * __longlong_as_double(0x3FE45F306DC9C883ull ^ z_));
    const double r = (x - k * __longlong_as_double(0x3FF921FB54400000ull ^ z_)) - k * __longlong_as_double(0x3DD0B4611A626331ull ^ z_);
    const double z = r * r;
    double ts = r, ss = r, tc = 1.0, sc = 1.0;
#pragma unroll 1
    for (int i = 1; i <= 10; ++i) { ts = -ts * z / (double)((2 * i) * (2 * i + 1)); ss += ts; tc = -tc * z / (double)((2 * i - 1) * (2 * i)); sc += tc; }
    const int q = ((int)k) & 3;
    s = (q == 0) ? ss : (q == 1) ? sc : (q == 2) ? -ss : -sc;
    c = (q == 0) ? sc : (q == 1) ? -ss : (q == 2) ? -sc : ss;
}

struct Args { const float* in[33]; float* out; unsigned char* ws; int ph_lo, ph_hi; };

struct InTab { const long long* p; unsigned char* base; __device__ __forceinline__ const float* operator[](int k) const { return (const float*)(base + p[k]); } };
struct Cx {
    InTab in; float* out; unsigned char* ws; unsigned char* lds;
    int tid, lane, wid, G, bid;
    int vG, vbid;
};
struct PArgs { float* out; unsigned char* ws; LAS unsigned char* lds; };
constexpr int LDS_TAB_OFF = LDS_BYTES - 16 - 272;
__device__ __forceinline__ Cx make_cx(const PArgs& pa) {
    unsigned long long zo_ = 0, zw_ = 0; asm volatile("" : "+s"(zo_), "+s"(zw_));
    float* o_ = (float*)((unsigned char*)pa.out + zo_); unsigned char* w_ = pa.ws + zw_;
    Cx c; c.lds = (unsigned char*)pa.lds; c.in.p = (const long long*)(c.lds + LDS_TAB_OFF); c.out = o_; c.ws = w_; c.in.base = w_;
    { int t_ = threadIdx.x; asm volatile("" : "+v"(t_)); c.tid = t_; } c.lane = c.tid & 63; c.wid = __builtin_amdgcn_readfirstlane(c.tid >> 6); c.G = gridDim.x; c.bid = blockIdx.x;
    c.vG = c.G; c.vbid = c.bid;
    return c;
}

__device__ __forceinline__ int mod_index(int r) { return r < NLAT ? (r >> 13) : 4; }
#define LATB(c) ((bf16*)((c).ws + WS_H))
#define HBUF(c) ((bf16*)((c).out))
#define SGGQ(c) ((unsigned char*)((c).out) + (size_t)MTOT * 2048)
__device__ __forceinline__ const float* in_row_f32(const Cx& c, int r) { return r < NLAT ? c.in[0] + (size_t)r * D : c.in[2] + (size_t)(r - NLAT) * D; }
__device__ __forceinline__ const float* mods_ptr(const Cx& c, int layer, int mi, int which) { return (const float*)(c.ws + WS_MODS) + ((size_t)(layer * 5 + mi) * 6144 + which * 1024); }

namespace g8 {
constexpr int BM = 256, BK = 64, HALF = 128, HTB = HALF * BK * 2, STAGE_BYTES = 8 * HTB;
__device__ __forceinline__ int lds_byte(int r, int c) { const int st = (r >> 4) * 2 + (c >> 5), rr = r & 15, cc = c & 31, ob = rr * 64 + cc * 2; return st * 1024 + (ob ^ (((ob >> 9) & 1) << 5)); }
__device__ __forceinline__ void stage_rc(int b, int& R, int& C) { const int st = b / 1024, sb = b % 1024, swz = sb ^ (((sb >> 9) & 1) << 5); R = (st >> 1) * 16 + swz / 64; C = (st & 1) * 32 + (swz % 64) / 2; }
__device__ __forceinline__ int perm32(int rho) { const int n = rho >> 4, i = rho & 15; return 8 * (i >> 2) + 4 * n + (i & 3); }

struct GUnit { const char* A0; const char* A1; const char* B0; const char* B1; int pm, pn, x0, x1, cont, par; };

__device__ __forceinline__ unsigned nig_inv(int nN) { return ((1u << 22) + 8u * (unsigned)nN - 1u) / (8u * (unsigned)nN); }
__device__ __forceinline__ bool tile_order(int L, int nM, int nN, unsigned inv, int& pm, int& pn) {
    const int nwg = nM * nN; if (L >= nwg) return false;
    int wgid = L; { const int q = nwg >> 3, r = nwg & 7, xcd = wgid & 7, off = wgid >> 3; wgid = (xcd < r ? xcd * (q + 1) : r * (q + 1) + (xcd - r) * q) + off; }
    const int nig = 8 * nN, gid = (int)(((unsigned)wgid * inv) >> 22), fm = gid * 8, gsz = (nM - fm) < 8 ? (nM - fm) : 8, w = wgid - gid * nig;
    if (gsz == 8) { pm = fm + (w & 7); pn = w >> 3; } else { pm = fm + (w % gsz); pn = w / gsz; }
    return true;
}

template <class Epi, class Src, bool GATHER>
__device__ __forceinline__ void gemm256(LAS unsigned char* lds, const Src& S, const Epi& E, const int nt, const int lda, const int ldb) {
    int tid_ = threadIdx.x; asm volatile("" : "+v"(tid_));
    const int tid = tid_, wid = __builtin_amdgcn_readfirstlane(tid >> 6), lane = tid & 63, wr = wid >> 2, wc = wid & 3, fr = lane & 15, fq = lane >> 4;
#ifndef G8_ORIGMAP
#define G8_ORIGMAP 0
#endif
#if G8_ORIGMAP
    unsigned voffA[2][2], voffB[2]; int sR = 0, sC = 0;
#pragma unroll
    for (int i = 0; i < 2; ++i) { int R, C; stage_rc(tid * 16 + i * 8192, R, C); const int Rb = Epi::PERM ? ((R & ~31) + perm32(R & 31)) : R;
        voffA[0][i] = voffA[1][i] = (unsigned)(R * lda + C) * 2u; voffB[i] = (unsigned)(Rb * ldb + C) * 2u; }
    const unsigned ldsw = (unsigned)wid * 1024u;
#else
    unsigned voffA[2], voffB; int sR, sC;
    { stage_rc(wid * 2048 + lane * 16, sR, sC); const int Rb = Epi::PERM ? ((sR & ~31) + perm32(sR & 31)) : sR;
      voffA[0] = voffA[1] = (unsigned)(sR * lda + sC) * 2u; voffB = (unsigned)(Rb * ldb + sC) * 2u; }
    const unsigned ldsw = (unsigned)wid * 2048u;
#endif
    const int aoff = lds_byte(wr * 64 + fr, fq * 8), boff = lds_byte(wc * 32 + fr, fq * 8);
#define G8_SA(b, h) (((b) * 2 + (h)) * HTB)
#define G8_SB(b, h) ((4 + (b) * 2 + (h)) * HTB)
#if G8_ORIGMAP
#define G8_STAGE(bufoff, gbase, voff) do { _Pragma("unroll") for (int _i = 0; _i < 2; ++_i) \
        __builtin_amdgcn_global_load_lds((const unsigned*)((const char*)(gbase) + (voff)[_i]), (LAS unsigned*)(lds + (bufoff) + ldsw + _i * 8192), 16, 0, 0); } while (0)
#else
#define G8_STAGE(bufoff, gbase, voff) do { _Pragma("unroll") for (int _i = 0; _i < 2; ++_i) \
        __builtin_amdgcn_global_load_lds((const unsigned*)((const char*)(gbase) + (voff) + _i * 64), (LAS unsigned*)(lds + (bufoff) + ldsw + _i * 1024), 16, 0, 0); } while (0)
#endif
#define G8_LDA(dst, b, h) do { _Pragma("unroll") for (int m = 0; m < 4; ++m) _Pragma("unroll") for (int k = 0; k < 2; ++k) dst[m][k] = *(const LAS bf16x8*)(lds + G8_SA(b, h) + aoff + m * 2048 + k * 1024); } while (0)
#define G8_LDB(dst, b, h) do { _Pragma("unroll") for (int n = 0; n < 2; ++n) _Pragma("unroll") for (int k = 0; k < 2; ++k) dst[n][k] = *(const LAS bf16x8*)(lds + G8_SB(b, h) + boff + n * 2048 + k * 1024); } while (0)
#define G8_MMA(ai, bj, At, Bt) do { __builtin_amdgcn_s_setprio(1); _Pragma("unroll") for (int m = 0; m < 4; ++m) _Pragma("unroll") for (int n = 0; n < 2; ++n) _Pragma("unroll") for (int k = 0; k < 2; ++k) \
        acc[ai][bj][m][n] = __builtin_amdgcn_mfma_f32_16x16x32_bf16(Bt[n][k], At[m][k], acc[ai][bj][m][n], 0, 0, 0); __builtin_amdgcn_s_setprio(0); } while (0)
#ifndef G8_DRAIN
#define G8_DRAIN 0
#endif
#if G8_DRAIN
#define G8_WAIT_V(n) asm volatile("s_waitcnt vmcnt(0)" ::: "memory")
#else
#define G8_WAIT_V(n) asm volatile("s_waitcnt vmcnt(" #n ")" ::: "memory")
#endif
#define G8_WAIT_L(n) asm volatile("s_waitcnt lgkmcnt(" #n ")" ::: "memory")
#define G8_BAR __builtin_amdgcn_s_barrier()
#define G8_SCHED __builtin_amdgcn_sched_barrier(0)
#if G8_ORIGMAP
#define G8_GOFF(u) do { } while (0)
#else
#define G8_GOFF(u) do { if constexpr (GATHER) { _Pragma("unroll") for (int _h = 0; _h < 2; ++_h) voffA[_h] = S.row_off(u, _h * 128 + sR) + (unsigned)sC * 2u; } } while (0)
#endif
    GUnit cur, nxt; int ui = 0;
    if (!S.next(0, cur)) return;
    cur.par = 0;
    S.a_ready(cur);
    G8_GOFF(cur);
    f32x4 acc[2][2][4][2];
#pragma unroll
    for (int a = 0; a < 2; ++a)
#pragma unroll
        for (int b = 0; b < 2; ++b)
#pragma unroll
            for (int m = 0; m < 4; ++m)
#pragma unroll
                for (int n = 0; n < 2; ++n) acc[a][b][m][n] = (f32x4){0.f, 0.f, 0.f, 0.f};
    bf16x8 At[4][2], B0[2][2], B1[2][2];
    G8_STAGE(G8_SB(0, 0), cur.B0, voffB); G8_STAGE(G8_SA(0, 0), cur.A0, voffA[0]); G8_STAGE(G8_SB(0, 1), cur.B1, voffB); G8_STAGE(G8_SA(0, 1), cur.A1, voffA[1]);
    if (wr == 1) G8_BAR;
    G8_WAIT_V(4); G8_BAR;
    G8_STAGE(G8_SB(1, 0), cur.B0 + 128, voffB); G8_STAGE(G8_SA(1, 0), cur.A0 + 128, voffA[0]); G8_STAGE(G8_SB(1, 1), cur.B1 + 128, voffB);
    G8_WAIT_V(6); G8_BAR;
    for (;;) {
        const bool has_next = S.next(ui + 1, nxt);
        if (!has_next) nxt = cur;
        nxt.par = (ui + 1) & 1;
        S.prefetch(cur, lds, wid, lane);
        unsigned nvoff[2] = {0u, 0u};
        if constexpr (GATHER) { _Pragma("unroll") for (int _h = 0; _h < 2; ++_h) nvoff[_h] = S.row_off(nxt, _h * 128 + sR) + (unsigned)sC * 2u; }
        for (int t = 0; t < nt; t += 2) {
            const bool last = (t == nt - 2);
            if (last && has_next) S.a_ready(nxt);
            const char* a0_2 = last ? nxt.A0 : cur.A0 + (size_t)(t + 2) * 128; const char* a1_2 = last ? nxt.A1 : cur.A1 + (size_t)(t + 2) * 128;
            const char* b0_2 = last ? nxt.B0 : cur.B0 + (size_t)(t + 2) * 128; const char* b1_2 = last ? nxt.B1 : cur.B1 + (size_t)(t + 2) * 128;
            G8_LDB(B0, 0, 0); G8_SCHED; G8_LDA(At, 0, 0); G8_STAGE(G8_SA(1, 1), cur.A1 + (size_t)(t + 1) * 128, voffA[1]);
            G8_WAIT_L(8); G8_BAR; G8_WAIT_L(0); G8_MMA(0, 0, At, B0); G8_BAR; G8_SCHED;
            if (GATHER && last) { voffA[0] = nvoff[0]; voffA[1] = nvoff[1]; }
            G8_LDB(B1, 0, 1); G8_STAGE(G8_SB(0, 0), b0_2, voffB);
            G8_BAR; G8_WAIT_L(0); G8_MMA(0, 1, At, B1); G8_BAR;
            G8_LDA(At, 0, 1); G8_STAGE(G8_SA(0, 0), a0_2, voffA[0]);
            G8_BAR; G8_WAIT_L(0); G8_MMA(1, 0, At, B0); G8_BAR; G8_SCHED;
            G8_STAGE(G8_SB(0, 1), b1_2, voffB);
            G8_WAIT_V(6); G8_BAR; G8_MMA(1, 1, At, B1); G8_BAR;
            G8_LDB(B0, 1, 0); G8_SCHED; G8_LDA(At, 1, 0); G8_STAGE(G8_SA(0, 1), a1_2, voffA[1]);
            G8_WAIT_L(8); G8_BAR; G8_WAIT_L(0); G8_MMA(0, 0, At, B0); G8_BAR; G8_SCHED;
            G8_LDB(B1, 1, 1); G8_STAGE(G8_SB(1, 0), b0_2 + 128, voffB);
            G8_BAR; G8_WAIT_L(0); G8_MMA(0, 1, At, B1); G8_BAR;
            G8_LDA(At, 1, 1); G8_STAGE(G8_SA(1, 0), a0_2 + 128, voffA[0]);
            G8_BAR; G8_WAIT_L(0); G8_MMA(1, 0, At, B0); G8_BAR; G8_SCHED;
            G8_STAGE(G8_SB(1, 1), b1_2 + 128, voffB);
            G8_WAIT_V(6); G8_BAR; G8_MMA(1, 1, At, B1); G8_BAR;
        }
        if (!cur.cont) {
            E(acc, cur, wr, wc, fr, fq);
            S.done(cur);
            if (has_next) {
#pragma unroll
                for (int a = 0; a < 2; ++a)
#pragma unroll
                    for (int b = 0; b < 2; ++b)
#pragma unroll
                        for (int m = 0; m < 4; ++m)
#pragma unroll
                            for (int n = 0; n < 2; ++n) acc[a][b][m][n] = (f32x4){0.f, 0.f, 0.f, 0.f};
            }
        }
        if (!has_next) break;
        cur = nxt; ++ui;
    }
    G8_WAIT_V(0);
    if (wr == 0) G8_BAR;
    G8_BAR;
#undef G8_SA
#undef G8_SB
#undef G8_STAGE
#undef G8_LDA
#undef G8_LDB
#undef G8_MMA
#undef G8_WAIT_V
#undef G8_WAIT_L
#undef G8_BAR
#undef G8_SCHED
#undef G8_GOFF
}
}

__device__ __forceinline__ void ph_mods(PArgs pa) {
    const Cx c = make_cx(pa);
    float* sl = (float*)c.lds;
    for (int i = c.tid; i < 5 * 1024; i += NTHR) { const int v = i >> 10, k = i & 1023; const float x = v < 4 ? c.in[1][v * 1024 + k] : c.in[3][k]; sl[i] = siluf_(x); }
    __syncthreads();
    float* red = sl + 5 * 1024;
    for (int unit = c.bid; unit < 2 * 96; unit += c.G) {
        const int l = unit / 96, n0 = (unit % 96) * 64, col = c.tid & 63, ks = c.tid >> 6;
        const float* w = c.in[4] + ((size_t)l * 1024 + ks * 128) * 6144 + n0 + col;
        float a[5] = {0.f, 0.f, 0.f, 0.f, 0.f};
#pragma unroll 8
        for (int k = 0; k < 128; ++k) { const float wv = w[(size_t)k * 6144];
#pragma unroll
            for (int v = 0; v < 5; ++v) a[v] += sl[v * 1024 + ks * 128 + k] * wv; }
#pragma unroll
        for (int v = 0; v < 5; ++v) red[(ks * 5 + v) * 64 + col] = a[v];
        __syncthreads();
        if (c.tid < 320) { const int v = c.tid >> 6, cc = c.tid & 63; float s = 0.f;
#pragma unroll
            for (int q = 0; q < 8; ++q) s += red[(q * 5 + v) * 64 + cc];
            ((float*)(c.ws + WS_MODS))[(size_t)(l * 5 + v) * 6144 + n0 + cc] = s + c.in[5][l * 6144 + n0 + cc]; }
        __syncthreads();
    }
}

struct XW { const char* a; const char* b; int split; };
__device__ __forceinline__ XW xw_set(const Cx& c, int set) {
    XW x; if (set == 0) { x.a = (const char*)(c.ws + WS_WEG); x.b = x.a; x.split = 64; } else { x.a = (const char*)c.out + X1_OUT_OFF; x.b = (const char*)(c.ws + WS_X1); x.split = X1_SPLIT; } return x; }
__device__ __forceinline__ const char* xw_ptr(const XW& x, int m) { return m < x.split ? x.a + ((size_t)m << 20) : x.b + ((size_t)(m - x.split) << 20); }

__device__ __forceinline__ void cvt_T(const Cx& c, int p, int P, const float* src, int ldsrc, size_t src_batch, int K, int N, bf16* dstA, bf16* dstB, int mb, int split, int ldd, int nbatch,
                                      int sc_lo, int sc_hi, float scale, int& tile_off, int glo, int ghi) {
    float* tl = (float*)c.lds;
    const int tk = K / 128, tn = N / 64, per = tk * tn, total = per * nbatch;
    const int a = (glo - tile_off) > 0 ? (glo - tile_off) : 0, b = (ghi - tile_off) < total ? (ghi - tile_off) : total;
    const int goff = tile_off + a - glo;
    tile_off += total;
    if (p < 0 || a >= b) return;
    const int t0 = a + ((p - goff % P) + P) % P;
    const int nn = c.tid & 63, k0 = c.tid >> 6;
    const int kp = (c.tid & 63) * 2, n0 = c.tid >> 6;
    float ta[16], tb2[16];
    auto issue = [&](int t) {
        const int tA = t < b ? t : (b - 1), tBq = (t + P) < b ? (t + P) : tA;
        const int biA = tA / per, rA = tA % per, ktA = rA / tn, ntA = rA % tn, biB = tBq / per, rB = tBq % per, ktB = rB / tn, ntB = rB % tn;
        const float* sA = src + (size_t)biA * src_batch + (size_t)(ktA * 128) * ldsrc + ntA * 64;
        const float* sB = src + (size_t)biB * src_batch + (size_t)(ktB * 128) * ldsrc + ntB * 64;
#pragma unroll
        for (int j = 0; j < 16; ++j) ta[j] = sA[(size_t)(k0 + 8 * j) * ldsrc + nn];
#pragma unroll
        for (int j = 0; j < 16; ++j) tb2[j] = sB[(size_t)(k0 + 8 * j) * ldsrc + nn];
    };
    if (t0 < b) issue(t0);
    for (int t = t0; t < b; t += 2 * P) {
        const int tB = t + P; const bool hasB = tB < b;
        const int biA = t / per, rA = t % per, ktA = rA / tn, ntA = rA % tn;
        const int tBc = hasB ? tB : t; const int biB = tBc / per, rB = tBc % per, ktB = rB / tn, ntB = rB % tn;
#pragma unroll
        for (int j = 0; j < 16; ++j) { tl[(k0 + 8 * j) * 65 + nn] = ta[j]; tl[8320 + (k0 + 8 * j) * 65 + nn] = tb2[j]; }
        asm volatile("s_waitcnt lgkmcnt(0)" ::: "memory"); __builtin_amdgcn_s_barrier();
        if (t + 2 * P < b) issue(t + 2 * P);
        const int mA = mb + biA, mB = mb + biB;
        bf16* dA = (mA < split ? dstA + ((size_t)mA << 19) : dstB + ((size_t)(mA - split) << 19)) + (size_t)(ntA * 64) * ldd + ktA * 128;
#pragma unroll
        for (int j = 0; j < 8; ++j) { const int n2 = n0 + 8 * j; const int ng = ntA * 64 + n2; const float f = (ng >= sc_lo && ng < sc_hi) ? scale : 1.0f;
            *(unsigned*)(dA + (size_t)n2 * ldd + kp) = cvt_pk_bf16(tl[kp * 65 + n2] * f, tl[(kp + 1) * 65 + n2] * f); }
        if (hasB) { bf16* dB = (mB < split ? dstA + ((size_t)mB << 19) : dstB + ((size_t)(mB - split) << 19)) + (size_t)(ntB * 64) * ldd + ktB * 128;
#pragma unroll
            for (int j = 0; j < 8; ++j) { const int n2 = n0 + 8 * j; const int ng = ntB * 64 + n2; const float f = (ng >= sc_lo && ng < sc_hi) ? scale : 1.0f;
                *(unsigned*)(dB + (size_t)n2 * ldd + kp) = cvt_pk_bf16(tl[8320 + kp * 65 + n2] * f, tl[8320 + (kp + 1) * 65 + n2] * f); } }
        asm volatile("s_waitcnt lgkmcnt(0)" ::: "memory"); __builtin_amdgcn_s_barrier();
    }
}

__device__ __forceinline__ void cvt_run(const Cx& c, int j_lo, int j_hi, int p, int P, int glo, int ghi) {
    int off = 0;
#pragma unroll 1
    for (int j = j_lo; j < j_hi; ++j) {
        const int l = j >= 9 ? 1 : 0, k = j < 9 ? j : (j < 12 ? j - 3 : j - 12), set = (j >= 9 && j < 12) ? 1 : 0;
        const float* src; int ldsrc, K, N, ldd, nbatch = 1, sc_lo = 0, sc_hi = 0, mb = 0, split = 1; size_t sb = 0; bf16* dA; bf16* dB;
        if (k < 2) {
            src = c.in[8] + (size_t)l * 1024 * 4096 + k * 2048; ldsrc = 4096; K = 1024; N = 2048; ldd = 1024; dA = (bf16*)(c.ws + (k == 0 ? WS_WIN : WS_WG)); if (k == 0) { sc_lo = 512; sc_hi = 768; } }
        else if (k < 5) { src = c.in[k == 2 ? 17 : (k == 3 ? 18 : 23)] + (size_t)l * 512 * 1024; ldsrc = 1024; K = 512; N = 1024; ldd = 512; dA = (bf16*)(c.ws + WS_WA + (size_t)(k - 2) * 1024 * 512 * 2); }
        else if (k == 5) { src = c.in[24] + (size_t)l * 1024 * 1024; ldsrc = 1024; K = 1024; N = 1024; ldd = 1024; dA = (bf16*)(c.ws + WS_WOUT); }
        else { const int kind = k - 6; src = c.in[29 + kind] + (size_t)l * 16 * 1024 * 512; sb = (size_t)1024 * 512; nbatch = 16; mb = kind * 16;
            if (kind < 2) { ldsrc = 512; K = 1024; N = 512; ldd = 1024; } else { ldsrc = 1024; K = 512; N = 1024; ldd = 512; }
            const XW x = xw_set(c, set); dA = (bf16*)x.a; split = x.split; dB = (bf16*)x.b; }
        if (k < 6) dB = dA;
        cvt_T(c, p, P, src, ldsrc, sb, K, N, dA, dB, mb, split, ldd, nbatch, sc_lo, sc_hi, 0.125f, off, glo, ghi);
    }
}
__device__ __forceinline__ void cvt_w1(const Cx& c, int l, int p, int P) {
    const float* w1 = c.in[19] + (size_t)l * 2 * 1024 * 16;
    bf16* win = (bf16*)(c.ws + WS_WIN);
    for (int i = (p < 0 ? 2 * 16 * 512 : p * NTHR + c.tid); i < 2 * 16 * 512; i += P * NTHR) {
        const int kp = (i & 511) * 2, j = (i >> 9) & 15, d = i >> 13;
        const float* a0 = w1 + ((size_t)d * 1024 + kp) * 16 + j;
        *(unsigned*)(win + (size_t)(2048 + d * 16 + j) * 1024 + kp) = cvt_pk_bf16(a0[0], a0[16]);
    }
}
#ifndef BG_CFG
#define BG_CFG 3072, 3072, 3072, 3072, 3072, 3072
#endif
constexpr int BG_TAB[6] = {BG_CFG};
constexpr int BG_X0 = BG_TAB[0], BG_F = BG_TAB[1], BG_G = BG_TAB[2], BG_H = BG_TAB[3], BG_J = BG_TAB[4], BG_K = BG_TAB[5];
static_assert(BG_X0 <= BG_F && BG_F <= BG_G && BG_G <= BG_H && BG_H >= 3072 && BG_H <= BG_J && BG_J <= BG_K && BG_K <= 6144, "background slices");
__device__ __forceinline__ void ph_convert(PArgs pa) {
    const Cx c = make_cx(pa);
    cvt_run(c, 0, 9, c.vbid, c.vG, 0, 832 + BG_X0);
    cvt_w1(c, 0, c.vbid, c.vG);
}
__device__ __forceinline__ void ph_bg(PArgs pa, int nunits, int glo, int ghi, bool w1) {
    const Cx c = make_cx(pa);
    const int extra = nunits % c.G; const int p = extra ? c.bid - extra : c.bid, P = extra ? c.G - extra : c.G;
    __syncthreads();
    cvt_run(c, 6, 18, p, P, glo, ghi);
    if (w1) { cvt_run(c, 6, 18, p, P, 6144, 6976); cvt_w1(c, 1, p, P); }
}
__device__ __forceinline__ void ph_convert1(PArgs pa) {
    const Cx c = make_cx(pa);
    if (BG_K < 6144) cvt_run(c, 6, 12, c.vbid, c.vG, BG_K, 6144);
}

__device__ __forceinline__ void ph_s5prep(PArgs pa, int l, int p, int P, int u_lo, int u_hi) {
    const Cx c = make_cx(pa);
    float2* apow = (float2*)c.lds;
    float2* bbar = apow + 2 * 17 * 64;
    float2* cc = bbar + 2 * 64 * 16;
    float* KT = (float*)(cc + 2 * 16 * 64);
    double* kk = (double*)(KT + 2 * 16 * 257);
    for (int unit = p < 0 ? u_hi : u_lo + p; unit < u_hi; unit += P) {
        const int g = unit >> 3, s8 = unit & 7;
        float brv[4], biv[4], ccr[4], cci[4];
#pragma unroll
        for (int q = 0; q < 4; ++q) { const int i = c.tid + NTHR * q, dir = i >> 10; const size_t gi = ((size_t)(l * 2 + dir) * 32 + g);
            brv[q] = c.in[12][gi * 1024 + (i & 1023)]; biv[q] = c.in[13][gi * 1024 + (i & 1023)]; ccr[q] = c.in[14][gi * 1024 + (i & 1023)]; cci[q] = c.in[15][gi * 1024 + (i & 1023)]; }
        if (c.tid < 128) {
            const int dir = c.tid >> 6, p = c.tid & 63; const size_t gi = ((size_t)(l * 2 + dir) * 32 + g);
            const double lr = (double)c.in[9][gi * 64 + p], li = (double)c.in[10][gi * 64 + p], dt = my_exp((double)c.in[11][gi]);
            double sn, cs; my_sincos(li * dt, sn, cs); const double mag = my_exp(lr * dt);
            const double a1r = mag * cs, a1i = mag * sn;
            unsigned long long zz_ = 0; asm volatile("" : "+s"(zz_));
            double ar = __longlong_as_double(0x3FF0000000000000ull ^ zz_), ai = __longlong_as_double(zz_);
            for (int d = 0; d <= 16; ++d) {
                apow[(dir * 17 + d) * 64 + p] = make_float2((float)ar, (float)ai);
                if (d == 16 && s8 == 0) ((float2*)(c.ws + WS_S5AT))[(dir * 32 + g) * 64 + p] = make_float2((float)ar, (float)ai);
                const double nr = ar * a1r - ai * a1i, ni = ar * a1i + ai * a1r; ar = nr; ai = ni; }
            const double den = lr * lr + li * li, kr = ((a1r - 1.0) * lr + a1i * li) / den, ki = (a1i * lr - (a1r - 1.0) * li) / den;
            kk[c.tid * 2] = kr; kk[c.tid * 2 + 1] = ki;
        }
#pragma unroll
        for (int q = 0; q < 4; ++q) cc[c.tid + NTHR * q] = make_float2(ccr[q], cci[q]);
        __syncthreads();
#pragma unroll
        for (int q = 0; q < 4; ++q) { const int i = c.tid + NTHR * q; const double kr = kk[(i >> 4) * 2], ki = kk[(i >> 4) * 2 + 1], br = (double)brv[q], bi = (double)biv[q];
            bbar[i] = make_float2((float)(kr * br - ki * bi), (float)(kr * bi + ki * br)); }
        __syncthreads();
        for (int e2 = c.tid; e2 < 1024; e2 += NTHR) {
            const int dir = e2 >> 9, d = (e2 >> 5) & 15, ho = 2 * s8 + ((e2 >> 4) & 1), h = e2 & 15; float s = 0.f;
            for (int p = 0; p < 64; ++p) { const float2 cv = cc[(dir * 16 + ho) * 64 + p], av = apow[(dir * 17 + d) * 64 + p], bv = bbar[(dir * 64 + p) * 16 + h];
                const float gr = cv.x * av.x - cv.y * av.y, gim = cv.x * av.y + cv.y * av.x; s += gr * bv.x - gim * bv.y; }
            KT[(dir * 16 + d) * 257 + ho * 16 + h] = s;
        }
        __syncthreads();
        bf16* we = (bf16*)(c.ws + WS_WE) + (size_t)g * 256 * 256;
        for (int i = c.tid; i < 32 * 128; i += NTHR) {
            const int n = 32 * s8 + (i >> 7), k = (i & 127) * 2; const int dir = n >> 7, im = (n >> 6) & 1, p = n & 63, j = k >> 4, h = k & 15, d = dir == 0 ? 15 - j : j;
            const float2 av = apow[(dir * 17 + d) * 64 + p], b0 = bbar[(dir * 64 + p) * 16 + h], b1 = bbar[(dir * 64 + p) * 16 + h + 1];
            const float v0 = im ? (av.x * b0.y + av.y * b0.x) : (av.x * b0.x - av.y * b0.y), v1 = im ? (av.x * b1.y + av.y * b1.x) : (av.x * b1.x - av.y * b1.y);
            *(unsigned*)(we + (size_t)n * 256 + k) = cvt_pk_bf16(v0, v1);
        }
        bf16* wy = (bf16*)(c.ws + WS_WY) + (size_t)g * 256 * 512;
        const float* dsk = c.in[16] + (size_t)l * 512 + g * 16;
        for (int i = c.tid; i < 32 * 256; i += NTHR) {
            const int r = i >> 8, k = (i & 255) * 2; const int ii = r >> 1, ho = 2 * s8 + (r & 1), n = ii * 16 + ho; float v[2];
#pragma unroll
            for (int q = 0; q < 2; ++q) { const int kq = k + q; float s;
                if (kq < 256) { const int j = kq >> 4, h = kq & 15; s = 0.f;
                    if (j <= ii) s += KT[(0 * 16 + (ii - j)) * 257 + ho * 16 + h];
                    if (j >= ii) s += KT[(1 * 16 + (j - ii)) * 257 + ho * 16 + h];
                    if (j == ii && h == ho) s += dsk[ho]; }
                else { const int kk = kq - 256, which = kk >> 6, p = kk & 63, dir = which >> 1, d = dir == 0 ? ii + 1 : 16 - ii;
                    const float2 cv = cc[(dir * 16 + ho) * 64 + p], av = apow[(dir * 17 + d) * 64 + p];
                    s = (which & 1) ? -(cv.x * av.y + cv.y * av.x) : (cv.x * av.x - cv.y * av.y); }
                v[q] = s; }
            *(unsigned*)(wy + (size_t)n * 512 + k) = cvt_pk_bf16(v[0], v[1]);
        }
        __syncthreads();
    }
}

__device__ __forceinline__ void ph_norm(PArgs pa, int l, int which, int M) {
    const Cx c = make_cx(pa);
    const float* gw = (which == 0 ? c.in[6] : c.in[7]) + (size_t)l * D;
    bf16* H = HBUF(c); const bf16* latb = LATB(c);
    const bool srcf = (which == 0 && l == 0);
    int* lcnt = (int*)c.lds;
    int* gbase = lcnt + 32;
    int* erow = lcnt + 64; int* ebkt = erow + 192; int* elpos = ebkt + 192; float2* ew = (float2*)(elpos + 192);
    float4* wgl = (float4*)(c.lds + 8192);
    float4* wel = wgl + 1024;
    float* bl = (float*)(wel + 4096);
    float4* gwl = (float4*)(c.lds + 90368);
    float4* shl = gwl + 256;
    float4* scl = shl + 5 * 256;
    for (int i2 = c.tid; i2 < 11 * 256; i2 += NTHR) { const int t = i2 >> 8, col4 = i2 & 255, ln = col4 & 63, j = col4 >> 6;
        const float4 v = t == 0 ? ((const float4*)gw)[ln + 64 * j] : ((const float4*)mods_ptr(c, l, (t - 1) % 5, (t <= 5 ? (which == 0 ? 0 : 3) : (which == 0 ? 1 : 4))))[ln + 64 * j];
        (t == 0 ? gwl : (t <= 5 ? shl + (t - 1) * 256 : scl + (t - 6) * 256))[j * 64 + ln] = v; }
    if (which == 0) __syncthreads();
    if (which == 1) {
        if (c.tid < 64) lcnt[c.tid] = 0;
        const float4* g25 = (const float4*)(c.in[25] + (size_t)l * D * 4); const float4* g27 = (const float4*)(c.in[27] + (size_t)l * 4 * D * 4);
        for (int i = c.tid; i < 5 * 1024; i += NTHR) { const int t = i >> 10, col = i & 1023; const int ln = (col & 255) >> 2, j = col >> 8, q = col & 3;
            const float4 v = t == 0 ? g25[col] : g27[(size_t)(t - 1) * 1024 + col];
            (t == 0 ? wgl : wel + (t - 1) * 1024)[(j * 4 + q) * 64 + ln] = v; }
        if (c.tid < 4) bl[c.tid] = c.in[26][l * 4 + c.tid]; else if (c.tid < 20) bl[c.tid] = c.in[28][l * 16 + (c.tid - 4)];
        __syncthreads();
    }
    const int nw = (which == 0 ? c.vG : c.G) * 8, gwid = which == 0 ? (c.vbid < 0 ? M : c.vbid * 8 + c.wid) : c.bid * 8 + c.wid, lane = c.lane;
    auto proc = [&](const int r, const float4 (&v)[4]) {
        float ss = 0.f;
#pragma unroll
        for (int j = 0; j < 4; ++j) ss += v[j].x * v[j].x + v[j].y * v[j].y + v[j].z * v[j].z + v[j].w * v[j].w;
        ss = wave_sum(ss);
        const float rstd = rsqrtf(ss * (1.0f / 1024.0f) + 1e-6f);
        const int mi = mod_index(r);
        float hv[16];
#pragma unroll
        for (int j = 0; j < 4; ++j) { const int col = 4 * lane + 256 * j; const float4 g4 = gwl[j * 64 + lane], s4 = scl[mi * 256 + j * 64 + lane], h4 = shl[mi * 256 + j * 64 + lane];
            hv[4 * j + 0] = v[j].x * rstd * g4.x * (1.f + s4.x) + h4.x; hv[4 * j + 1] = v[j].y * rstd * g4.y * (1.f + s4.y) + h4.y;
            hv[4 * j + 2] = v[j].z * rstd * g4.z * (1.f + s4.z) + h4.z; hv[4 * j + 3] = v[j].w * rstd * g4.w * (1.f + s4.w) + h4.w;
            uint2 w; w.x = cvt_pk_bf16(hv[4 * j], hv[4 * j + 1]); w.y = cvt_pk_bf16(hv[4 * j + 2], hv[4 * j + 3]); *(uint2*)(H + (size_t)r * D + col) = w; }
        if (which == 1) {
            float gl[4] = {0.f, 0.f, 0.f, 0.f};
#pragma unroll
            for (int j = 0; j < 4; ++j)
#pragma unroll
                for (int q = 0; q < 4; ++q) { const float4 w4 = wgl[(j * 4 + q) * 64 + lane]; const float h = hv[4 * j + q];
                    gl[0] += h * w4.x; gl[1] += h * w4.y; gl[2] += h * w4.z; gl[3] += h * w4.w; }
#pragma unroll
            for (int q = 0; q < 4; ++q) gl[q] = wave_sum(gl[q]) + bl[q];
            int grp = 0; float gm = gl[0];
#pragma unroll
            for (int q = 1; q < 4; ++q) if (gl[q] > gm) { gm = gl[q]; grp = q; }
            float den = 0.f;
#pragma unroll
            for (int q = 0; q < 4; ++q) den += __expf(gl[q] - gm);
            const float pgrp = 1.0f / den;
            const float4* wre = wel + grp * 1024;
            float el[4] = {0.f, 0.f, 0.f, 0.f};
#pragma unroll
            for (int j = 0; j < 4; ++j)
#pragma unroll
                for (int q = 0; q < 4; ++q) { const float4 w4 = wre[(j * 4 + q) * 64 + lane]; const float h = hv[4 * j + q];
                    el[0] += h * w4.x; el[1] += h * w4.y; el[2] += h * w4.z; el[3] += h * w4.w; }
#pragma unroll
            for (int q = 0; q < 4; ++q) el[q] = wave_sum(el[q]) + bl[4 + grp * 4 + q];
            int ia = 0; float va = el[0];
#pragma unroll
            for (int q = 1; q < 4; ++q) if (el[q] > va) { va = el[q]; ia = q; }
            int ib = -1; float vb = -3.0e38f;
#pragma unroll
            for (int q = 0; q < 4; ++q) if (q != ia && el[q] > vb) { vb = el[q]; ib = q; }
            const float eb = __expf(vb - va), wa = pgrp / (1.0f + eb), wb = pgrp * eb / (1.0f + eb);
            const int lo = ia < ib ? ia : ib, hi = ia < ib ? ib : ia; const float wlo = ia < ib ? wa : wb, whi = ia < ib ? wb : wa;
            const int pair = lo == 0 ? hi - 1 : (lo == 1 ? hi + 1 : 5);
            const int bkt = grp * 6 + pair;
            if (lane == 0) { const int lp = atomicAdd(&lcnt[bkt], 1); const int e = atomicAdd(&lcnt[31], 1); erow[e] = r; ebkt[e] = bkt; elpos[e] = lp; ew[e] = make_float2(wlo, whi); }
        }
        };
    for (int r = gwid; r < M; r += 2 * nw) {
        const int r1 = r + nw; const bool has1 = r1 < M;
        const int r1c = has1 ? r1 : r;
        float4 v0[4], v1[4];
        if (srcf) {
            const float* src0 = in_row_f32(c, r); const float* src1 = in_row_f32(c, r1c);
#pragma unroll
            for (int j = 0; j < 4; ++j) v0[j] = *(const float4*)(src0 + 4 * lane + 256 * j);
#pragma unroll
            for (int j = 0; j < 4; ++j) v1[j] = *(const float4*)(src1 + 4 * lane + 256 * j);
        } else {
            uint2 w0[4], w1[4];
#pragma unroll
            for (int j = 0; j < 4; ++j) w0[j] = *(const uint2*)(latb + (size_t)r * D + 4 * lane + 256 * j);
#pragma unroll
            for (int j = 0; j < 4; ++j) w1[j] = *(const uint2*)(latb + (size_t)r1c * D + 4 * lane + 256 * j);
#pragma unroll
            for (int j = 0; j < 4; ++j) { v0[j] = make_float4(bflo(w0[j].x), bfhi(w0[j].x), bflo(w0[j].y), bfhi(w0[j].y)); v1[j] = make_float4(bflo(w1[j].x), bfhi(w1[j].x), bflo(w1[j].y), bfhi(w1[j].y)); }
        }
        proc(r, v0);
        if (has1) proc(r1, v1);
    }
    if (which == 1) {
        __syncthreads();
        unsigned* gcnt = (unsigned*)(c.ws + WS_CTL + CTL_CNT_OFF) + l * 32;
        if (c.tid < 24) gbase[c.tid] = (int)__hip_atomic_fetch_add(&gcnt[c.tid], (unsigned)lcnt[c.tid], __ATOMIC_RELAXED, __HIP_MEMORY_SCOPE_AGENT);
        __syncthreads();
        const int ne = lcnt[31];
        int* perm = (int*)(c.ws + WS_PERM); float2* pw = (float2*)(c.ws + WS_PW);
        for (int e = c.tid; e < ne; e += NTHR) { const int b = ebkt[e]; const size_t pos = (size_t)b * CAP + gbase[b] + elpos[e]; perm[pos] = erow[e]; pw[pos] = ew[e]; }
        __syncthreads();
    }
}

__device__ __forceinline__ void ph_final(PArgs pa) {
    const Cx c = make_cx(pa);
    const float* gw = c.in[32]; const bf16* latb = LATB(c);
    const int nw = c.G * 8, gwid = c.bid * 8 + c.wid, lane = c.lane;
    float4 g4[4];
#pragma unroll
    for (int j = 0; j < 4; ++j) g4[j] = *(const float4*)(gw + 4 * lane + 256 * j);
    for (int r = gwid; r < NLAT; r += 2 * nw) {
        const int r1 = r + nw; const bool has1 = r1 < NLAT; const int r1c = has1 ? r1 : r;
        uint2 w0[4], w1[4];
#pragma unroll
        for (int j = 0; j < 4; ++j) w0[j] = *(const uint2*)(latb + (size_t)r * D + 4 * lane + 256 * j);
#pragma unroll
        for (int j = 0; j < 4; ++j) w1[j] = *(const uint2*)(latb + (size_t)r1c * D + 4 * lane + 256 * j);
        float4 v0[4], v1[4]; float ss0 = 0.f, ss1 = 0.f;
#pragma unroll
        for (int j = 0; j < 4; ++j) { v0[j] = make_float4(bflo(w0[j].x), bfhi(w0[j].x), bflo(w0[j].y), bfhi(w0[j].y)); v1[j] = make_float4(bflo(w1[j].x), bfhi(w1[j].x), bflo(w1[j].y), bfhi(w1[j].y));
            ss0 += v0[j].x * v0[j].x + v0[j].y * v0[j].y + v0[j].z * v0[j].z + v0[j].w * v0[j].w; ss1 += v1[j].x * v1[j].x + v1[j].y * v1[j].y + v1[j].z * v1[j].z + v1[j].w * v1[j].w; }
        ss0 = wave_sum(ss0); ss1 = wave_sum(ss1);
        const float rs0 = rsqrtf(ss0 * (1.0f / 1024.0f) + 1e-6f), rs1 = rsqrtf(ss1 * (1.0f / 1024.0f) + 1e-6f);
        float* s0 = c.out + (size_t)r * D; float* s1 = c.out + (size_t)r1c * D;
#pragma unroll
        for (int j = 0; j < 4; ++j) { const int col = 4 * lane + 256 * j;
            float4 o; o.x = v0[j].x * rs0 * g4[j].x; o.y = v0[j].y * rs0 * g4[j].y; o.z = v0[j].z * rs0 * g4[j].z; o.w = v0[j].w * rs0 * g4[j].w; *(float4*)(s0 + col) = o; }
        if (has1) {
#pragma unroll
            for (int j = 0; j < 4; ++j) { const int col = 4 * lane + 256 * j;
                float4 o; o.x = v1[j].x * rs1 * g4[j].x; o.y = v1[j].y * rs1 * g4[j].y; o.z = v1[j].z * rs1 * g4[j].z; o.w = v1[j].w * rs1 * g4[j].w; *(float4*)(s1 + col) = o; }
        }
    }
}

__device__ __forceinline__ int gla_row(int b, int pc, int i) { return pc < 2 ? NLAT + b * 256 + pc * 128 + i : b * 8192 + i * 64 + (pc - 2); }
__device__ __forceinline__ size_t gla_state_idx(int b, int dir, int pc, int h) { return ((size_t)((b * 2 + dir) * NPC + pc) * 4 + h) * 8192; }

__device__ __forceinline__ void gla_deal(const Cx& c, int nunits, bool skew, int& u0, int& u1, int& step) {
    if (skew && c.G == 256 && nunits >= 992) { const int e5 = nunits - 992, b = c.bid;
        if (b < 32) { u0 = 3 * b; u1 = u0 + 3; } else if (b < 32 + e5) { u0 = 96 + 5 * (b - 32); u1 = u0 + 5; } else { u0 = 96 + 5 * e5 + 4 * (b - 32 - e5); u1 = u0 + 4; }
        step = 1; }
    else { u0 = c.bid; u1 = nunits; step = c.G; }
}
struct GlaIn { uint4 q[2], k[2], v[4], t1; };
__device__ __forceinline__ void gla_kv_load(const bf16* proj, const bf16* t1b, int b, int pc, int h, int i, int part, GlaIn& r) {
    const int row = gla_row(b, pc, i);
    const bf16* rp = proj + (size_t)row * 2048;
    const uint4* p;
    p = (const uint4*)(rp + PQ + h * 64 + part * 16); r.q[0] = p[0]; r.q[1] = p[1];
    p = (const uint4*)(rp + PK + h * 64 + part * 16); r.k[0] = p[0]; r.k[1] = p[1];
    p = (const uint4*)(rp + PV + h * 128 + part * 32); r.v[0] = p[0]; r.v[1] = p[1]; r.v[2] = p[2]; r.v[3] = p[3];
    r.t1 = *(const uint4*)(t1b + (size_t)row * 32 + part * 8);
}
__device__ __forceinline__ void ph_gla_kv(PArgs pa, int l, bool skew) {
    const Cx c = make_cx(pa);
    constexpr int LAS_ = 68;
    float* LA = (float*)c.lds;
    float* tot = (float*)(c.lds + 69632);
    bf16* KTt = (bf16*)(c.lds + 73728);
    bf16* T1s = KTt;
    bf16* W2s = KTt + 2 * 128 * 40;
    bf16* VT = (bf16*)(c.lds + 73728 + 2 * 64 * 136 * 2);
    bf16* proj = (bf16*)(c.ws + WS_PROJ); const bf16* t1b = (const bf16*)(c.ws + WS_T1);
    bf16* kvb = (bf16*)(c.ws + WS_KVB); float* dec = (float*)(c.ws + WS_DEC);
    const float* w2g = c.in[20] + (size_t)l * 2 * 16 * 256; const float* bg = c.in[21] + (size_t)l * 2 * 256;
    const int lane = c.lane, fr = lane & 15, fq = lane >> 4;
    const int i = c.tid >> 2, part = c.tid & 3;
    const int nunits = 4 * NPC * 4;
    GlaIn in;
    int unit, uend, ustep; gla_deal(c, nunits, skew, unit, uend, ustep);
    float* bgl = (float*)(c.lds + 143360);
    bgl[c.tid] = bg[c.tid];
    const int d2_ = c.tid >> 8, ch_ = (c.tid >> 2) & 63, jq_ = c.tid & 3;
    float w2r[4] = {0.f, 0.f, 0.f, 0.f};
    if (unit < uend) { gla_kv_load(proj, t1b, unit / (4 * NPC), (unit >> 2) % NPC, unit & 3, i, part, in);
        const float* wp = w2g + ((size_t)d2_ * 16 + jq_ * 4) * 256 + (unit & 3) * 64 + ch_; w2r[0] = wp[0]; w2r[1] = wp[256]; w2r[2] = wp[512]; w2r[3] = wp[768]; }
    __syncthreads();
    for (; unit < uend; unit += ustep) {
        const int h = unit & 3, pc = (unit >> 2) % NPC, b = unit / (4 * NPC);
        const int row = gla_row(b, pc, i);
        const unsigned qw[8] = {in.q[0].x, in.q[0].y, in.q[0].z, in.q[0].w, in.q[1].x, in.q[1].y, in.q[1].z, in.q[1].w};
        const unsigned kw[8] = {in.k[0].x, in.k[0].y, in.k[0].z, in.k[0].w, in.k[1].x, in.k[1].y, in.k[1].z, in.k[1].w};
        {
            const int d = part >> 1, c0 = (part & 1) * 8;
            *(uint4*)(T1s + (d * 128 + i) * 40 + c0) = in.t1; *(uint4*)(T1s + (d * 128 + i) * 40 + 16 + c0) = make_uint4(0u, 0u, 0u, 0u);
            const int d2 = d2_, ch = ch_, jq = jq_;
            uint2 wv; wv.x = cvt_pk_bf16(w2r[0], w2r[1]); wv.y = cvt_pk_bf16(w2r[2], w2r[3]);
            *(uint2*)(W2s + (d2 * 64 + ch) * 40 + jq * 4) = wv; *(uint2*)(W2s + (d2 * 64 + ch) * 40 + 16 + jq * 4) = make_uint2(0u, 0u);
        }
        __syncthreads();
        {
            const float sc = 0.0625f * 1.4426950408889634f;
#pragma unroll
            for (int d = 0; d < 2; ++d) {
                const bf16x8 tf = *(const bf16x8*)(T1s + (d * 128 + c.wid * 16 + fr) * 40 + fq * 8);
#pragma unroll
                for (int n = 0; n < 4; ++n) {
                    const bf16x8 wf = *(const bf16x8*)(W2s + (d * 64 + n * 16 + fr) * 40 + fq * 8);
                    f32x4 z = (f32x4){0.f, 0.f, 0.f, 0.f};
                    z = __builtin_amdgcn_mfma_f32_16x16x32_bf16(wf, tf, z, 0, 0, 0);
                    const float4 b4 = *(const float4*)(bgl + d * 256 + h * 64 + n * 16 + fq * 4);
                    const float x0 = z[0] + b4.x, x1 = z[1] + b4.y, x2 = z[2] + b4.z, x3 = z[3] + b4.w;
                    float4 o;
                    o.x = (fminf(x0, 0.f) - __logf(1.0f + __expf(-fabsf(x0)))) * sc; o.y = (fminf(x1, 0.f) - __logf(1.0f + __expf(-fabsf(x1)))) * sc;
                    o.z = (fminf(x2, 0.f) - __logf(1.0f + __expf(-fabsf(x2)))) * sc; o.w = (fminf(x3, 0.f) - __logf(1.0f + __expf(-fabsf(x3)))) * sc;
                    *(float4*)(LA + (d * 128 + c.wid * 16 + fr) * LAS_ + n * 16 + fq * 4) = o;
                }
            }
        }
        {
            const uint4 vq[4] = {in.v[0], in.v[1], in.v[2], in.v[3]};
#pragma unroll
            for (int q = 0; q < 4; ++q) { const unsigned ww[4] = {vq[q].x, vq[q].y, vq[q].z, vq[q].w};
#pragma unroll
                for (int j = 0; j < 4; ++j) { const int vv = part * 32 + q * 8 + 2 * j, ix = i ^ (16 * part); VT[vv * 136 + ix] = (bf16)(ww[j] & 0xffffu); VT[(vv + 1) * 136 + ix] = (bf16)(ww[j] >> 16); } }
        }
        __syncthreads();
        {
            const int kk = c.tid & 63, seg = c.tid >> 6;
            float rf = 0.f, rb = 0.f;
#pragma unroll
            for (int j = 0; j < 16; ++j) { const int t0 = seg * 16 + j, t1 = seg * 16 + 15 - j; rf += LA[(0 * 128 + t0) * LAS_ + kk]; LA[(0 * 128 + t0) * LAS_ + kk] = rf; rb += LA[(1 * 128 + t1) * LAS_ + kk]; LA[(1 * 128 + t1) * LAS_ + kk] = rb; }
            tot[(0 * 8 + seg) * 64 + kk] = rf; tot[(1 * 8 + seg) * 64 + kk] = rb;
            __syncthreads();
            float of = 0.f, ob = 0.f;
#pragma unroll
            for (int s2 = 0; s2 < 8; ++s2) { const float tf = tot[(0 * 8 + s2) * 64 + kk], tb2 = tot[(1 * 8 + s2) * 64 + kk]; of += s2 < seg ? tf : 0.f; ob += s2 > seg ? tb2 : 0.f; }
#pragma unroll
            for (int j = 0; j < 16; ++j) { LA[(0 * 128 + seg * 16 + j) * LAS_ + kk] += of; LA[(1 * 128 + seg * 16 + j) * LAS_ + kk] += ob; }
            __syncthreads();
        }
        {
            bf16* rp = proj + (size_t)row * 2048;
            unsigned oqf[8], oqb[8], okf[8], okb[8];
#pragma unroll
            for (int j = 0; j < 8; ++j) {
                const int kk = part * 16 + 2 * j;
                const float2 bf2 = *(const float2*)(LA + (0 * 128 + i) * LAS_ + kk), bb2 = *(const float2*)(LA + (1 * 128 + i) * LAS_ + kk);
                const float2 ef2 = *(const float2*)(LA + (0 * 128 + 127) * LAS_ + kk), eb2 = *(const float2*)(LA + (1 * 128 + 0) * LAS_ + kk);
                const float q0 = bflo(qw[j]), q1 = bfhi(qw[j]), k0 = bflo(kw[j]), k1 = bfhi(kw[j]);
                oqf[j] = cvt_pk_bf16(q0 * __builtin_amdgcn_exp2f(bf2.x), q1 * __builtin_amdgcn_exp2f(bf2.y));
                oqb[j] = cvt_pk_bf16(q0 * __builtin_amdgcn_exp2f(bb2.x), q1 * __builtin_amdgcn_exp2f(bb2.y));
                okf[j] = cvt_pk_bf16(k0 * __builtin_amdgcn_exp2f(-bf2.x), k1 * __builtin_amdgcn_exp2f(-bf2.y));
                okb[j] = cvt_pk_bf16(k0 * __builtin_amdgcn_exp2f(-bb2.x), k1 * __builtin_amdgcn_exp2f(-bb2.y));
                const int ix = i ^ (16 * part);
                KTt[(0 * 64 + kk) * 136 + ix] = f2bf(k0 * __builtin_amdgcn_exp2f(ef2.x - bf2.x)); KTt[(0 * 64 + kk + 1) * 136 + ix] = f2bf(k1 * __builtin_amdgcn_exp2f(ef2.y - bf2.y));
                KTt[(1 * 64 + kk) * 136 + ix] = f2bf(k0 * __builtin_amdgcn_exp2f(eb2.x - bb2.x)); KTt[(1 * 64 + kk + 1) * 136 + ix] = f2bf(k1 * __builtin_amdgcn_exp2f(eb2.y - bb2.y));
            }
            uint4* o;
            o = (uint4*)(rp + PQ + h * 64 + part * 16); o[0] = make_uint4(oqf[0], oqf[1], oqf[2], oqf[3]); o[1] = make_uint4(oqf[4], oqf[5], oqf[6], oqf[7]);
            o = (uint4*)(rp + PK + h * 64 + part * 16); o[0] = make_uint4(oqb[0], oqb[1], oqb[2], oqb[3]); o[1] = make_uint4(oqb[4], oqb[5], oqb[6], oqb[7]);
            o = (uint4*)(rp + PZF + h * 64 + part * 16); o[0] = make_uint4(okf[0], okf[1], okf[2], okf[3]); o[1] = make_uint4(okf[4], okf[5], okf[6], okf[7]);
            o = (uint4*)(rp + PZB + h * 64 + part * 16); o[0] = make_uint4(okb[0], okb[1], okb[2], okb[3]); o[1] = make_uint4(okb[4], okb[5], okb[6], okb[7]);
            if (c.tid < 128) { const int d = c.tid >> 6, kk = c.tid & 63; dec[((size_t)((b * 2 + d) * NPC + pc) * 4 + h) * 64 + kk] = __builtin_amdgcn_exp2f(LA[(d * 128 + (d == 0 ? 127 : 0)) * LAS_ + kk]); }
        }
        { const int nu = unit + ustep; if (nu < uend) { gla_kv_load(proj, t1b, nu / (4 * NPC), (nu >> 2) % NPC, nu & 3, i, part, in);
            const float* wp = w2g + ((size_t)d2_ * 16 + jq_ * 4) * 256 + (nu & 3) * 64 + ch_; w2r[0] = wp[0]; w2r[1] = wp[256]; w2r[2] = wp[512]; w2r[3] = wp[768]; } }
        __syncthreads();
        f32x4 acc[2][4];
#pragma unroll
        for (int d = 0; d < 2; ++d)
#pragma unroll
            for (int n = 0; n < 4; ++n) acc[d][n] = (f32x4){0.f, 0.f, 0.f, 0.f};
#pragma unroll
        for (int ks = 0; ks < 4; ++ks) {
            const bf16x8 vf = *(const bf16x8*)(VT + (c.wid * 16 + fr) * 136 + ((ks * 32 + fq * 8) ^ (16 * (c.wid >> 1))));
#pragma unroll
            for (int d = 0; d < 2; ++d)
#pragma unroll
                for (int n = 0; n < 4; ++n) { const bf16x8 kf = *(const bf16x8*)(KTt + (d * 64 + n * 16 + fr) * 136 + ((ks * 32 + fq * 8) ^ (16 * n)));
                    acc[d][n] = __builtin_amdgcn_mfma_f32_16x16x32_bf16(kf, vf, acc[d][n], 0, 0, 0); }
        }
#pragma unroll
        for (int d = 0; d < 2; ++d)
#pragma unroll
            for (int n = 0; n < 4; ++n) store_bf16x4(kvb + gla_state_idx(b, d, pc, h) + (size_t)(c.wid * 16 + fr) * 64 + n * 16 + fq * 4, acc[d][n]);
        __syncthreads();
    }
}

__device__ __forceinline__ int s5_chain_br(int b, int dir, int j) {
    if (dir == 0) return j < 16 ? 2048 + b * 16 + j : b * 512 + (j - 16);
    return j < 16 ? 2048 + b * 16 + (15 - j) : b * 512 + (527 - j);
}
__device__ __forceinline__ void ph_scan(PArgs pa) {
    const Cx c = make_cx(pa);
    float2* segend = (float2*)c.lds;
    const bf16* eb = (const bf16*)(c.ws + WS_EB); bf16* usb = (bf16*)(c.ws + WS_USB);
    for (int unit = c.bid; unit < 256; unit += c.G) {
        const int b = unit >> 6, dir = (unit >> 5) & 1, g = unit & 31, p = c.tid & 63, seg = c.tid >> 6;
        const float2 aT = ((const float2*)(c.ws + WS_S5AT))[(dir * 32 + g) * 64 + p];
        float sr = 0.f, si = 0.f;
        const bf16* ebase = eb + (size_t)g * BRP * 256 + dir * 128 + p;
        float er[66], ei[66];
#pragma unroll
        for (int q = 0; q < 66; ++q) { const bf16* e = ebase + (size_t)s5_chain_br(b, dir, seg * 66 + q) * 256; er[q] = bf2f(e[0]); ei[q] = bf2f(e[64]); }
#pragma unroll
        for (int q = 0; q < 66; ++q) { const float nr = aT.x * sr - aT.y * si + er[q], ni = aT.x * si + aT.y * sr + ei[q]; sr = nr; si = ni; }
        segend[seg * 64 + p] = make_float2(sr, si);
        float pr = 1.f, pi = 0.f;
        for (int q = 0; q < 66; ++q) { const float nr = pr * aT.x - pi * aT.y, ni = pr * aT.y + pi * aT.x; pr = nr; pi = ni; }
        __syncthreads();
        sr = 0.f; si = 0.f;
        for (int s2 = 0; s2 < seg; ++s2) { const float2 e = segend[s2 * 64 + p]; const float nr = pr * sr - pi * si + e.x, ni = pr * si + pi * sr + e.y; sr = nr; si = ni; }
        bf16* obase = usb + (size_t)g * BRP * 512 + 256 + dir * 128 + p;
#pragma unroll
        for (int q = 0; q < 66; ++q) { bf16* o = obase + (size_t)s5_chain_br(b, dir, seg * 66 + q) * 512; o[0] = f2bf(sr); o[64] = f2bf(si);
            const float nr = aT.x * sr - aT.y * si + er[q], ni = aT.x * si + aT.y * sr + ei[q]; sr = nr; si = ni; }
        __syncthreads();
    }
    const unsigned* kvb = (const unsigned*)(c.ws + WS_KVB); unsigned* sst = (unsigned*)(c.ws + WS_SST); const float* dec = (const float*)(c.ws + WS_DEC);
    for (int e2 = c.bid * NTHR + c.tid; e2 < 4 * 2 * 4 * 4096; e2 += c.G * NTHR) {
        const int chain = e2 >> 12, within = (e2 & 4095) * 2, kk = within & 63; const int h = chain & 3, dir = (chain >> 2) & 1, b = chain >> 3;
        float s0 = 0.f, s1 = 0.f;
#pragma unroll 1
        for (int j0 = 0; j0 < NPC; j0 += 22) {
            unsigned kv[22]; float2 d2[22];
#pragma unroll
            for (int q = 0; q < 22; ++q) { const int j = j0 + q, pc = dir == 0 ? j : (j < 2 ? 1 - j : 67 - j);
                kv[q] = kvb[(gla_state_idx(b, dir, pc, h) + within) >> 1]; d2[q] = *(const float2*)(dec + ((size_t)((b * 2 + dir) * NPC + pc) * 4 + h) * 64 + kk); }
#pragma unroll
            for (int q = 0; q < 22; ++q) { const int j = j0 + q, pc = dir == 0 ? j : (j < 2 ? 1 - j : 67 - j);
                sst[(gla_state_idx(b, dir, pc, h) + within) >> 1] = cvt_pk_bf16(s0, s1); s0 = d2[q].x * s0 + bflo(kv[q]); s1 = d2[q].y * s1 + bfhi(kv[q]); }
        }
    }
}

typedef unsigned gu4 __attribute__((ext_vector_type(4)));
struct GlaOutIn { gu4 qf0, qf1, qb0, qb1, kf0, kf1, kb0, kb1, v0, v1, v2, v3; };
__device__ __forceinline__ void gla_out_load(const bf16* proj, int b, int pc, int h, int i, int part, GlaOutIn& r) {
    const bf16* rp = proj + (size_t)gla_row(b, pc, i) * 2048;
    const gu4* p;
    p = (const gu4*)(rp + PQ + h * 64 + part * 16); r.qf0 = p[0]; r.qf1 = p[1];
    p = (const gu4*)(rp + PK + h * 64 + part * 16); r.qb0 = p[0]; r.qb1 = p[1];
    p = (const gu4*)(rp + PZF + h * 64 + part * 16); r.kf0 = p[0]; r.kf1 = p[1];
    p = (const gu4*)(rp + PZB + h * 64 + part * 16); r.kb0 = p[0]; r.kb1 = p[1];
    p = (const gu4*)(rp + PV + h * 128 + part * 32); r.v0 = p[0]; r.v1 = p[1]; r.v2 = p[2]; r.v3 = p[3];
}
__device__ __forceinline__ void ph_gla_out(PArgs pa, int l, int pc_lo, bool skew) {
    const Cx c = make_cx(pa);
    bf16* P = (bf16*)c.lds;
    bf16* Q2 = (bf16*)(c.lds + 34816);
    bf16* KI = (bf16*)(c.lds + 69632);
    bf16* S2T = KI;
    bf16* VT = (bf16*)(c.lds + 106496);
    const bf16* proj = (const bf16*)(c.ws + WS_PROJ); const bf16* sst = (const bf16*)(c.ws + WS_SST); bf16* ob = (bf16*)(c.ws + WS_OB);
    const float* gn = c.in[22] + (size_t)l * 128;
    const int lane = c.lane, fr = lane & 15, fq = lane >> 4, w = c.wid;
    const int i = c.tid >> 2, part = c.tid & 3;
    const int npc = NPC - pc_lo, nunits = 4 * npc * 4;
    GlaOutIn in;
    int unit, uend, ustep; gla_deal(c, nunits, skew, unit, uend, ustep);
    float* gnl = (float*)(c.lds + 141312);
    if (c.tid < 128) gnl[c.tid] = gn[c.tid];
    if (unit < uend) gla_out_load(proj, unit / (4 * npc), pc_lo + (unit >> 2) % npc, unit & 3, i, part, in);
    for (; unit < uend; unit += ustep) {
        const int h = unit & 3, pc = pc_lo + (unit >> 2) % npc, b = unit / (4 * npc);
        typedef unsigned u4_t __attribute__((ext_vector_type(4)));
        const bf16* sp0 = sst + gla_state_idx(b, 0, pc, h) + (size_t)c.tid * 8; const bf16* sp1 = sst + gla_state_idx(b, 1, pc, h) + (size_t)c.tid * 8;
        const u4_t s00 = *(const u4_t*)(sp0), s01 = *(const u4_t*)(sp0 + 4096);
        const u4_t s10 = *(const u4_t*)(sp1), s11 = *(const u4_t*)(sp1 + 4096);
        const int orow = gla_row(b, pc, w * 16 + fr);
        typedef unsigned u2_t __attribute__((ext_vector_type(2)));
        u2_t rreg[8];
#pragma unroll
        for (int n = 0; n < 8; ++n) rreg[n] = *(const u2_t*)(proj + (size_t)orow * 2048 + PR + h * 128 + n * 16 + fq * 4);
        *(gu4*)(Q2 + i * 136 + part * 16) = in.qf0; *(gu4*)(Q2 + i * 136 + part * 16 + 8) = in.qf1;
        *(gu4*)(Q2 + i * 136 + 64 + part * 16) = in.qb0; *(gu4*)(Q2 + i * 136 + 64 + part * 16 + 8) = in.qb1;
        *(gu4*)(KI + (0 * 128 + i) * 72 + part * 16) = in.kf0; *(gu4*)(KI + (0 * 128 + i) * 72 + part * 16 + 8) = in.kf1;
        *(gu4*)(KI + (1 * 128 + i) * 72 + part * 16) = in.kb0; *(gu4*)(KI + (1 * 128 + i) * 72 + part * 16 + 8) = in.kb1;
        {
            const gu4 vq[4] = {in.v0, in.v1, in.v2, in.v3};
#pragma unroll
            for (int q = 0; q < 4; ++q) { const unsigned ww[4] = {vq[q].x, vq[q].y, vq[q].z, vq[q].w};
#pragma unroll
                for (int j = 0; j < 4; ++j) { const int vv = part * 32 + q * 8 + 2 * j, ix = i ^ (16 * part); VT[vv * 136 + ix] = (bf16)(ww[j] & 0xffffu); VT[(vv + 1) * 136 + ix] = (bf16)(ww[j] >> 16); } }
        }
        { const int nu = unit + ustep; if (nu < uend) gla_out_load(proj, nu / (4 * npc), pc_lo + (nu >> 2) % npc, nu & 3, i, part, in); }
        __syncthreads();
        {
            bf16x8 qf[2][2];
#pragma unroll
            for (int d = 0; d < 2; ++d)
#pragma unroll
                for (int ks = 0; ks < 2; ++ks) qf[d][ks] = *(const bf16x8*)(Q2 + (w * 16 + fr) * 136 + d * 64 + ks * 32 + fq * 8);
#pragma unroll 1
            for (int nt = 0; nt < 8; ++nt) {
                f32x4 pf = (f32x4){0.f, 0.f, 0.f, 0.f}, pb = (f32x4){0.f, 0.f, 0.f, 0.f};
                if (nt <= w) {
#pragma unroll
                    for (int ks = 0; ks < 2; ++ks) { const bf16x8 kf = *(const bf16x8*)(KI + (0 * 128 + nt * 16 + fr) * 72 + ks * 32 + fq * 8); pf = __builtin_amdgcn_mfma_f32_16x16x32_bf16(kf, qf[0][ks], pf, 0, 0, 0); } }
                if (nt >= w) {
#pragma unroll
                    for (int ks = 0; ks < 2; ++ks) { const bf16x8 kf = *(const bf16x8*)(KI + (1 * 128 + nt * 16 + fr) * 72 + ks * 32 + fq * 8); pb = __builtin_amdgcn_mfma_f32_16x16x32_bf16(kf, qf[1][ks], pb, 0, 0, 0); } }
                const int t = w * 16 + fr; f32x4 pv;
#pragma unroll
                for (int rg = 0; rg < 4; ++rg) { const int s2 = nt * 16 + fq * 4 + rg; pv[rg] = (s2 <= t ? pf[rg] : 0.f) + (s2 >= t ? pb[rg] : 0.f); }
                store_bf16x4(P + t * 136 + nt * 16 + fq * 4, pv);
            }
        }
        __syncthreads();
        { bf16* d0 = S2T + (c.tid >> 3) * 136 + (c.tid & 7) * 8;
          *(u4_t*)(d0) = s00; *(u4_t*)(d0 + 64 * 136) = s01;
          *(u4_t*)(d0 + 64) = s10; *(u4_t*)(d0 + 64 * 136 + 64) = s11; }
        __syncthreads();
        f32x4 acc[8];
#pragma unroll
        for (int n = 0; n < 8; ++n) acc[n] = (f32x4){0.f, 0.f, 0.f, 0.f};
#pragma unroll
        for (int ks = 0; ks < 4; ++ks) {
            const bf16x8 pa2 = *(const bf16x8*)(P + (w * 16 + fr) * 136 + ks * 32 + fq * 8);
#pragma unroll
            for (int n = 0; n < 8; ++n) { const bf16x8 vf = *(const bf16x8*)(VT + (n * 16 + fr) * 136 + ((ks * 32 + fq * 8) ^ (16 * (n >> 1)))); acc[n] = __builtin_amdgcn_mfma_f32_16x16x32_bf16(vf, pa2, acc[n], 0, 0, 0); }
        }
#pragma unroll
        for (int ks = 0; ks < 4; ++ks) {
            const bf16x8 qa = *(const bf16x8*)(Q2 + (w * 16 + fr) * 136 + ks * 32 + fq * 8);
#pragma unroll
            for (int n = 0; n < 8; ++n) { const bf16x8 sf = *(const bf16x8*)(S2T + (n * 16 + fr) * 136 + ks * 32 + fq * 8); acc[n] = __builtin_amdgcn_mfma_f32_16x16x32_bf16(sf, qa, acc[n], 0, 0, 0); }
        }
        float ss = 0.f;
#pragma unroll
        for (int n = 0; n < 8; ++n) ss += acc[n][0] * acc[n][0] + acc[n][1] * acc[n][1] + acc[n][2] * acc[n][2] + acc[n][3] * acc[n][3];
        ss += __shfl_xor(ss, 16); ss += __shfl_xor(ss, 32);
        const float rstd = rsqrtf(ss * (1.0f / 128.0f) + 1e-6f);
#pragma unroll
        for (int n = 0; n < 8; ++n) { const int vv = n * 16 + fq * 4; const float4 g4 = *(const float4*)(gnl + vv);
            const u2_t rw = rreg[n];
            f32x4 o; o[0] = acc[n][0] * rstd * g4.x * siluf_(bflo(rw.x)); o[1] = acc[n][1] * rstd * g4.y * siluf_(bfhi(rw.x));
            o[2] = acc[n][2] * rstd * g4.z * siluf_(bflo(rw.y)); o[3] = acc[n][3] * rstd * g4.w * siluf_(bfhi(rw.y));
            store_bf16x4(ob + (size_t)orow * 512 + h * 128 + vv, o); }
        __syncthreads();
    }
}

typedef unsigned u32x4 __attribute__((ext_vector_type(4)));
constexpr int LDS_MOE_TAB = 131072;
constexpr int LDS_EPI_TAB = 131072 + 2048;
__device__ __forceinline__ u32x4 pack8(const f32x4& a, const f32x4& b) { u32x4 w; w.x = cvt_pk_bf16(a[0], a[1]); w.y = cvt_pk_bf16(a[2], a[3]); w.z = cvt_pk_bf16(b[0], b[1]); w.w = cvt_pk_bf16(b[2], b[3]); return w; }

struct PlainSrc {
    const char* A; const char* B; int lda2, ldb2, nM, nN, G, c; unsigned inv;
    __device__ __forceinline__ bool next(int i, g8::GUnit& u) const {
        int pm, pn; if (!g8::tile_order(i * G + c, nM, nN, inv, pm, pn)) return false;
        u.pm = pm; u.pn = pn; u.x0 = 0; u.x1 = 0;
        u.A0 = A + (size_t)pm * 256 * lda2; u.A1 = u.A0 + (size_t)128 * lda2; u.B0 = B + (size_t)pn * 256 * ldb2; u.B1 = u.B0 + (size_t)128 * ldb2; u.cont = 0; return true; }
    __device__ __forceinline__ unsigned row_off(const g8::GUnit&, int) const { return 0u; }
    __device__ __forceinline__ void a_ready(const g8::GUnit&) const {}
    __device__ __forceinline__ void done(const g8::GUnit&) const {}
    __device__ __forceinline__ void prefetch(const g8::GUnit&, LAS unsigned char*, int, int) const {}
};
struct DualSrc {
    const char* A; const char* W0; const char* W1; int lda2, ldb2, nM, nN, G, c; unsigned inv;
    __device__ __forceinline__ bool next(int i, g8::GUnit& u) const {
        int pm, pn; if (!g8::tile_order(i * G + c, nM, nN, inv, pm, pn)) return false;
        u.pm = pm; u.pn = pn; u.x0 = 0; u.x1 = 0;
        u.A0 = A + (size_t)pm * 256 * lda2; u.A1 = u.A0 + (size_t)128 * lda2; u.B0 = W0 + (size_t)pn * 128 * ldb2; u.B1 = W1 + (size_t)pn * 128 * ldb2; u.cont = 0; return true; }
    __device__ __forceinline__ unsigned row_off(const g8::GUnit&, int) const { return 0u; }
    __device__ __forceinline__ void a_ready(const g8::GUnit&) const {}
    __device__ __forceinline__ void done(const g8::GUnit&) const {}
    __device__ __forceinline__ void prefetch(const g8::GUnit&, LAS unsigned char*, int, int) const {}
};
struct BatchSrc {
    const char* A; const char* W; int lda2, ldb2, nMg, G, c;
    __device__ __forceinline__ bool next(int i, g8::GUnit& u) const {
        const int L = i * G + c; if (L >= 32 * nMg) return false;
        const int g = L / nMg, pm = L % nMg; u.pm = pm; u.pn = 0; u.x0 = g; u.x1 = 0;
        u.A0 = A + ((size_t)g * BRP + pm * 256) * lda2; u.A1 = u.A0 + (size_t)128 * lda2; u.B0 = W + (size_t)g * 256 * ldb2; u.B1 = u.B0 + (size_t)128 * ldb2; u.cont = 0; return true; }
    __device__ __forceinline__ unsigned row_off(const g8::GUnit&, int) const { return 0u; }
    __device__ __forceinline__ void a_ready(const g8::GUnit&) const {}
    __device__ __forceinline__ void done(const g8::GUnit&) const {}
    __device__ __forceinline__ void prefetch(const g8::GUnit&, LAS unsigned char*, int, int) const {}
};

struct EpiWin {
    static constexpr bool PERM = true;
    bf16* usb; bf16* proj; bf16* t1b; unsigned char* sg5q; unsigned char* sggq;
    __device__ __forceinline__ void operator()(const f32x4 (&acc)[2][2][4][2], const g8::GUnit& u, int wr, int wc, int fr, int fq) const {
        if (u.pn < 9) {
#pragma unroll
            for (int ai = 0; ai < 2; ++ai)
#pragma unroll
                for (int m = 0; m < 4; ++m) { const int row = u.pm * 256 + ai * 128 + wr * 64 + m * 16 + fr;
#pragma unroll
                    for (int bj = 0; bj < 2; ++bj) { const int col = u.pn * 256 + bj * 128 + wc * 32 + 8 * fq; const u32x4 w = pack8(acc[ai][bj][m][0], acc[ai][bj][m][1]);
                        if (col < 512) *(u32x4*)(usb + ((size_t)((col >> 4) * BRP + (row >> 4)) * 512 + (row & 15) * 16 + (col & 15))) = w;
                        else if (col < 2048) *(u32x4*)(proj + (size_t)row * 2048 + (col - 512)) = w;
                        else if (col < 2080) *(u32x4*)(t1b + (size_t)row * 32 + (col - 2048)) = w; } }
        } else {
            unsigned char* base = (u.pn < 13) ? sg5q : sggq; const int c0 = (u.pn - (u.pn < 13 ? 9 : 13)) * 256 + wc * 32 + 8 * fq;
#pragma unroll
            for (int ai = 0; ai < 2; ++ai)
#pragma unroll
                for (int m = 0; m < 4; ++m) { const int row = u.pm * 256 + ai * 128 + wr * 64 + m * 16 + fr;
#pragma unroll
                    for (int bj = 0; bj < 2; ++bj) { unsigned w[2];
#pragma unroll
                        for (int n = 0; n < 2; ++n) { unsigned q = 0;
#pragma unroll
                            for (int j = 0; j < 4; ++j) q |= (unsigned)__builtin_rintf(255.0f * sigmoidf_(acc[ai][bj][m][n][j])) << (8 * j);
                            w[n] = q; }
                        *(uint2*)(base + (size_t)row * 1024 + c0 + bj * 128) = make_uint2(w[0], w[1]); } }
        }
    }
};
struct EpiS5E {
    static constexpr bool PERM = true;
    bf16* eb;
    __device__ __forceinline__ void operator()(const f32x4 (&acc)[2][2][4][2], const g8::GUnit& u, int wr, int wc, int fr, int fq) const {
#pragma unroll
        for (int ai = 0; ai < 2; ++ai)
#pragma unroll
            for (int m = 0; m < 4; ++m) { const int row = u.pm * 256 + ai * 128 + wr * 64 + m * 16 + fr;
#pragma unroll
                for (int bj = 0; bj < 2; ++bj) { const int col = bj * 128 + wc * 32 + 8 * fq;
                    *(u32x4*)(eb + ((size_t)u.x0 * BRP + row) * 256 + col) = pack8(acc[ai][bj][m][0], acc[ai][bj][m][1]); } }
    }
};
struct EpiS5Y {
    static constexpr bool PERM = true;
    bf16* ab; int nbr;
    __device__ __forceinline__ void operator()(const f32x4 (&acc)[2][2][4][2], const g8::GUnit& u, int wr, int wc, int fr, int fq) const {
#pragma unroll
        for (int ai = 0; ai < 2; ++ai)
#pragma unroll
            for (int m = 0; m < 4; ++m) { const int row = u.pm * 256 + ai * 128 + wr * 64 + m * 16 + fr;
                if (row < nbr) {
#pragma unroll
                    for (int bj = 0; bj < 2; ++bj) { const int col = bj * 128 + wc * 32 + 8 * fq; f32x4 a = acc[ai][bj][m][0], b = acc[ai][bj][m][1];
#pragma unroll
                        for (int j = 0; j < 4; ++j) { a[j] = gelu_tanh(a[j]); b[j] = gelu_tanh(b[j]); }
                        *(u32x4*)(ab + ((size_t)row * 16 + (col >> 4)) * 512 + u.x0 * 16 + (col & 15)) = pack8(a, b); } } }
    }
};
struct EpiBf16 {
    static constexpr bool PERM = true;
    bf16* O; int ldo; int act;
    __device__ __forceinline__ void operator()(const f32x4 (&acc)[2][2][4][2], const g8::GUnit& u, int wr, int wc, int fr, int fq) const {
#pragma unroll
        for (int ai = 0; ai < 2; ++ai)
#pragma unroll
            for (int m = 0; m < 4; ++m) { const int row = u.pm * 256 + ai * 128 + wr * 64 + m * 16 + fr;
#pragma unroll
                for (int bj = 0; bj < 2; ++bj) { const int col = u.pn * 256 + bj * 128 + wc * 32 + 8 * fq; f32x4 a = acc[ai][bj][m][0], b = acc[ai][bj][m][1];
                    if (act) {
#pragma unroll
                        for (int j = 0; j < 4; ++j) { a[j] = sigmoidf_(a[j]); b[j] = sigmoidf_(b[j]); } }
                    *(u32x4*)(O + (size_t)row * ldo + col) = pack8(a, b); } }
    }
};
struct EpiMerge {
    static constexpr bool PERM = true;
    const unsigned char* sg5q; const unsigned char* sggq; const bf16* yg; bf16* mg;
    __device__ __forceinline__ void operator()(const f32x4 (&acc)[2][2][4][2], const g8::GUnit& u, int wr, int wc, int fr, int fq) const {
        const int col = u.pn * 128 + wc * 32 + 8 * fq; const int row00 = u.pm * 256 + wr * 64 + fr;
        const unsigned char* s5base = sg5q + (size_t)row00 * 1024 + col; const unsigned char* sgbase = sggq + (size_t)row00 * 1024 + col;
        const bf16* ybase = yg + (size_t)row00 * 1024 + col; bf16* mbase = mg + (size_t)row00 * 1024 + col;
        uint2 s5c = *(const uint2*)(s5base), sgc = *(const uint2*)(sgbase), s5n, sgn; u32x4 yc = *(const u32x4*)(ybase), yn;
        const float k = 1.0f / 255.0f;
#pragma unroll
        for (int gi = 0; gi < 8; ++gi) { const int ai = gi >> 2, m = gi & 3; const size_t ro = (size_t)(ai * 128 + m * 16);
            if (gi + 1 < 8) { const size_t rn = (size_t)(((gi + 1) >> 2) * 128 + ((gi + 1) & 3) * 16); s5n = *(const uint2*)(s5base + rn * 1024); sgn = *(const uint2*)(sgbase + rn * 1024); yn = *(const u32x4*)(ybase + rn * 1024); }
            f32x4 o0, o1;
#pragma unroll
            for (int j = 0; j < 4; ++j) {
                const float s50 = (float)((s5c.x >> (8 * j)) & 255u) * k, s51 = (float)((s5c.y >> (8 * j)) & 255u) * k, sg0 = (float)((sgc.x >> (8 * j)) & 255u) * k, sg1 = (float)((sgc.y >> (8 * j)) & 255u) * k;
                const float y0 = (j & 1) ? bfhi(yc[j >> 1]) : bflo(yc[j >> 1]), y1 = (j & 1) ? bfhi(yc[2 + (j >> 1)]) : bflo(yc[2 + (j >> 1)]);
                o0[j] = acc[ai][0][m][0][j] * sigmoidf_(acc[ai][1][m][0][j]) * s50 + sg0 * y0;
                o1[j] = acc[ai][0][m][1][j] * sigmoidf_(acc[ai][1][m][1][j]) * s51 + sg1 * y1; }
            *(u32x4*)(mbase + ro * 1024) = pack8(o0, o1);
            asm volatile("" ::: "memory");
            s5c = s5n; sgc = sgn; yc = yn; }
    }
};
struct EpiWout {
    static constexpr bool PERM = true;
    const float* x0; const float* x1; bf16* latb; const float* mods; int l;
    __device__ __forceinline__ void operator()(const f32x4 (&acc)[2][2][4][2], const g8::GUnit& u, int wr, int wc, int fr, int fq) const {
        const int row00 = u.pm * 256 + wr * 64 + fr; const int cbase = u.pn * 256 + wc * 32 + 8 * fq;
        const float* gp = mods + ((size_t)(l * 5 + mod_index(row00)) * 6144 + 2 * 1024) + cbase;
        f32x4 g4[2][2];
#pragma unroll
        for (int bj = 0; bj < 2; ++bj)
#pragma unroll
            for (int n = 0; n < 2; ++n) g4[bj][n] = *(const f32x4*)(gp + bj * 128 + 4 * n);
        bf16* obase = latb + (size_t)row00 * D + cbase;
        if (l == 0) {
            const float* ibase = (row00 < NLAT ? x0 + (size_t)row00 * D : x1 + (size_t)(row00 - NLAT) * D) + cbase;
            f32x4 xc[2][2], xn[2][2];
#pragma unroll
            for (int bj = 0; bj < 2; ++bj)
#pragma unroll
                for (int n = 0; n < 2; ++n) xc[bj][n] = *(const f32x4*)(ibase + bj * 128 + 4 * n);
#pragma unroll
            for (int gi = 0; gi < 8; ++gi) { const int ai = gi >> 2, m = gi & 3; const size_t roff = (size_t)(ai * 128 + m * 16) * D;
                if (gi + 1 < 8) { const size_t rn = (size_t)(((gi + 1) >> 2) * 128 + ((gi + 1) & 3) * 16) * D;
#pragma unroll
                    for (int bj = 0; bj < 2; ++bj)
#pragma unroll
                        for (int n = 0; n < 2; ++n) xn[bj][n] = *(const f32x4*)(ibase + rn + bj * 128 + 4 * n); }
#pragma unroll
                for (int bj = 0; bj < 2; ++bj) *(u32x4*)(obase + roff + bj * 128) = pack8(xc[bj][0] + g4[bj][0] * acc[ai][bj][m][0], xc[bj][1] + g4[bj][1] * acc[ai][bj][m][1]);
                asm volatile("" ::: "memory");
#pragma unroll
                for (int bj = 0; bj < 2; ++bj)
#pragma unroll
                    for (int n = 0; n < 2; ++n) xc[bj][n] = xn[bj][n]; }
        } else {
            u32x4 xc[2], xn[2];
#pragma unroll
            for (int bj = 0; bj < 2; ++bj) xc[bj] = *(const u32x4*)(obase + bj * 128);
#pragma unroll
            for (int gi = 0; gi < 8; ++gi) { const int ai = gi >> 2, m = gi & 3; const size_t roff = (size_t)(ai * 128 + m * 16) * D;
                if (gi + 1 < 8) { const size_t rn = (size_t)(((gi + 1) >> 2) * 128 + ((gi + 1) & 3) * 16) * D;
#pragma unroll
                    for (int bj = 0; bj < 2; ++bj) xn[bj] = *(const u32x4*)(obase + rn + bj * 128); }
#pragma unroll
                for (int bj = 0; bj < 2; ++bj) { const f32x4 a0 = (f32x4){bflo(xc[bj][0]), bfhi(xc[bj][0]), bflo(xc[bj][1]), bfhi(xc[bj][1])}, a1 = (f32x4){bflo(xc[bj][2]), bfhi(xc[bj][2]), bflo(xc[bj][3]), bfhi(xc[bj][3])};
                    *(u32x4*)(obase + roff + bj * 128) = pack8(a0 + g4[bj][0] * acc[ai][bj][m][0], a1 + g4[bj][1] * acc[ai][bj][m][1]); }
                asm volatile("" ::: "memory");
#pragma unroll
                for (int bj = 0; bj < 2; ++bj) xc[bj] = xn[bj]; }
        }
    }
};

struct Moe1Src {
    const char* H; XW xw; const int* perm; const LAS int* tb; int T, G, c; unsigned* ready; const float* pw;
    __device__ __forceinline__ bool next(int i, g8::GUnit& u) const {
        const int L = i * G + c; if (L >= T * 8) return false;
        const int Tm = T & ~7; int tau, sq; if (L < Tm * 8) { const int x = L & 7, idx = L >> 3; tau = (idx & ~7) + x; sq = idx & 7; } else { tau = L >> 3; sq = L & 7; }
        const int slot = sq >> 2, q = sq & 3; const int te = __builtin_amdgcn_readfirstlane(tb[64 + tau]); const int bk = te & 255;
        const int tloc = te >> 8, cnt = __builtin_amdgcn_readfirstlane(tb[32 + bk]); const int pair = bk % 6; const int lo = pair < 3 ? 0 : (pair < 5 ? 1 : 2), hi = pair < 3 ? pair + 1 : (pair < 5 ? pair - 1 : 3);
        const int e = (bk / 6) * 4 + (slot ? hi : lo);
        u.pm = tau; u.pn = q; u.x0 = bk | (slot << 8) | (tloc << 16); u.x1 = cnt;
        u.A0 = H; u.A1 = H; u.B0 = xw_ptr(xw, e) + (size_t)(q * 128) * 2048; u.B1 = xw_ptr(xw, 16 + e) + (size_t)(q * 128) * 2048; u.cont = 0; return true; }
    __device__ __forceinline__ unsigned row_off(const g8::GUnit& u, int r) const {
        const int bk = u.x0 & 255, tloc = u.x0 >> 16; int pos = tloc * 256 + r; pos = pos < u.x1 ? pos : u.x1 - 1;
        return (unsigned)perm[(size_t)bk * CAP + pos] * 2048u; }
    __device__ __forceinline__ void a_ready(const g8::GUnit&) const {}
    __device__ __forceinline__ void prefetch(const g8::GUnit& u, LAS unsigned char* lds, int wid, int lane) const {
        if (wid < 4) { const int bk = u.x0 & 255, slot = (u.x0 >> 8) & 1, tloc = u.x0 >> 16; int pos = tloc * 256 + wid * 64 + lane; pos = pos < u.x1 ? pos : u.x1 - 1;
            __builtin_amdgcn_global_load_lds((const unsigned*)(pw + ((size_t)bk * CAP + pos) * 2 + slot), (LAS unsigned*)(lds + LDS_EPI_TAB + u.par * 1024 + wid * 256), 4, 0, 0); }
    }
    __device__ __forceinline__ void done(const g8::GUnit& u) const {
        asm volatile("s_waitcnt vmcnt(0)" ::: "memory");
        if ((threadIdx.x & 63) == 0) __hip_atomic_fetch_add(ready + (size_t)u.pm * TILE_STRIDE, 1u, __ATOMIC_RELAXED, __HIP_MEMORY_SCOPE_AGENT);
    }
};
struct EpiMoe1 {
    static constexpr bool PERM = true;
    bf16* hid; const LAS float* wtab;
    __device__ __forceinline__ void operator()(const f32x4 (&acc)[2][2][4][2], const g8::GUnit& u, int wr, int wc, int fr, int fq) const {
        const int slot = (u.x0 >> 8) & 1;
        const __amdgpu_buffer_rsrc_t rs = __builtin_amdgcn_make_buffer_rsrc(hid, 0, TILE_CAP * 256 * 2048, 0x00020000);
        float wv[8];
#pragma unroll
        for (int gi = 0; gi < 8; ++gi) { const int r = (gi >> 2) * 128 + wr * 64 + (gi & 3) * 16 + fr; wv[gi] = wtab[u.par * 256 + r]; }
#pragma unroll
        for (int gi = 0; gi < 8; ++gi) { const int ai = gi >> 2, m = gi & 3; const int r = ai * 128 + wr * 64 + m * 16 + fr; f32x4 o0, o1;
#pragma unroll
            for (int j = 0; j < 4; ++j) { o0[j] = siluf_(acc[ai][0][m][0][j]) * acc[ai][1][m][0][j] * wv[gi]; o1[j] = siluf_(acc[ai][0][m][1][j]) * acc[ai][1][m][1][j] * wv[gi]; }
            __builtin_amdgcn_raw_buffer_store_b128(pack8(o0, o1), rs, (unsigned)((((size_t)u.pm * 256 + r) * 1024 + slot * 512 + u.pn * 128 + wc * 32 + 8 * fq) * 2), 0,   16); }
    }
};
struct Moe2Src {
    const char* hid; XW xw; const LAS int* tb; int T, G, c; const unsigned* ready; const int* perm;
    __device__ __forceinline__ bool next(int i, g8::GUnit& u) const {
        const int L = (i >> 1) * G + c, seg = i & 1; if (L >= T * 4) return false;
        const int Tm = T & ~7; int tau, pn; if (L < Tm * 4) { const int x = L & 7, idx = L >> 3; tau = (idx >> 2) * 8 + x; pn = idx & 3; } else { tau = L >> 2; pn = L & 3; }
        const int te = __builtin_amdgcn_readfirstlane(tb[64 + tau]); const int bk = te & 255;
        const int tloc = te >> 8, cnt = __builtin_amdgcn_readfirstlane(tb[32 + bk]); const int pair = bk % 6; const int lo = pair < 3 ? 0 : (pair < 5 ? 1 : 2), hi = pair < 3 ? pair + 1 : (pair < 5 ? pair - 1 : 3);
        const int e = (bk / 6) * 4 + (seg ? hi : lo);
        u.pm = tau; u.pn = pn; u.x0 = bk | (tloc << 16); u.x1 = cnt; u.cont = seg ? 0 : 1;
        u.A0 = hid + (size_t)tau * 256 * 2048 + seg * 1024; u.A1 = u.A0 + (size_t)128 * 2048;
        u.B0 = xw_ptr(xw, 32 + e) + (size_t)(pn * 256) * 1024; u.B1 = u.B0 + (size_t)128 * 1024; return true; }
    __device__ __forceinline__ unsigned row_off(const g8::GUnit&, int) const { return 0u; }
    __device__ __forceinline__ void a_ready(const g8::GUnit& u) const {
        if (u.cont) {
            if (threadIdx.x < 64) {
                unsigned spins = 0;
                while ((unsigned)__builtin_amdgcn_readfirstlane(__hip_atomic_load(ready + (size_t)u.pm * TILE_STRIDE, __ATOMIC_RELAXED, __HIP_MEMORY_SCOPE_AGENT)) < 64u) {
                    __builtin_amdgcn_s_sleep(2); if (++spins > (1u << 18)) break; }
                __builtin_amdgcn_fence(__ATOMIC_ACQUIRE, "agent");
                asm volatile("s_waitcnt vmcnt(0)" ::: "memory");
            }
            asm volatile("" ::: "memory"); __builtin_amdgcn_s_barrier(); asm volatile("" ::: "memory");
        }
    }
    __device__ __forceinline__ void done(const g8::GUnit&) const {}
    __device__ __forceinline__ void prefetch(const g8::GUnit& u, LAS unsigned char* lds, int wid, int lane) const {
        if (wid < 4) { const int bk = u.x0 & 255, tloc = u.x0 >> 16; int pos = tloc * 256 + wid * 64 + lane; pos = pos < u.x1 ? pos : u.x1 - 1;
            __builtin_amdgcn_global_load_lds((const unsigned*)(perm + (size_t)bk * CAP + pos), (LAS unsigned*)(lds + LDS_EPI_TAB + u.par * 1024 + wid * 256), 4, 0, 0); }
    }
};
struct EpiMoe2 {
    static constexpr bool PERM = true;
    bf16* latb; const float* mods; const LAS int* ttab; int l;
    __device__ __forceinline__ void operator()(const f32x4 (&acc)[2][2][4][2], const g8::GUnit& u, int wr, int wc, int fr, int fq) const {
        const int tloc = u.x0 >> 16, cnt = u.x1;
        const int cbase = u.pn * 256 + wc * 32 + 8 * fq;
        int tok[8];
#pragma unroll
        for (int gi = 0; gi < 8; ++gi) { const int r = (gi >> 2) * 128 + wr * 64 + (gi & 3) * 16 + fr; tok[gi] = ttab[u.par * 256 + r]; }
        u32x4 xc[2], xn[2]; f32x4 gc[2][2], gn2[2][2];
        { const int t0 = tok[0]; const bf16* op = latb + (size_t)t0 * D + cbase; const float* gp = mods + ((size_t)(l * 5 + mod_index(t0)) * 6144 + 5 * 1024) + cbase;
#pragma unroll
          for (int bj = 0; bj < 2; ++bj) { xc[bj] = *(const u32x4*)(op + bj * 128); gc[bj][0] = *(const f32x4*)(gp + bj * 128); gc[bj][1] = *(const f32x4*)(gp + bj * 128 + 4); } }
#pragma unroll
        for (int gi = 0; gi < 8; ++gi) { const int ai = gi >> 2, m = gi & 3; const int r = ai * 128 + wr * 64 + m * 16 + fr, pos = tloc * 256 + r;
            if (gi + 1 < 8) { const int t1 = tok[gi + 1]; const bf16* op = latb + (size_t)t1 * D + cbase; const float* gp = mods + ((size_t)(l * 5 + mod_index(t1)) * 6144 + 5 * 1024) + cbase;
#pragma unroll
                for (int bj = 0; bj < 2; ++bj) { xn[bj] = *(const u32x4*)(op + bj * 128); gn2[bj][0] = *(const f32x4*)(gp + bj * 128); gn2[bj][1] = *(const f32x4*)(gp + bj * 128 + 4); } }
            if (pos < cnt) { bf16* op = latb + (size_t)tok[gi] * D + cbase;
#pragma unroll
                for (int bj = 0; bj < 2; ++bj) { const f32x4 a0 = (f32x4){bflo(xc[bj][0]), bfhi(xc[bj][0]), bflo(xc[bj][1]), bfhi(xc[bj][1])}, a1 = (f32x4){bflo(xc[bj][2]), bfhi(xc[bj][2]), bflo(xc[bj][3]), bfhi(xc[bj][3])};
                    *(u32x4*)(op + bj * 128) = pack8(a0 + gc[bj][0] * acc[ai][bj][m][0], a1 + gc[bj][1] * acc[ai][bj][m][1]); } }
            asm volatile("" ::: "memory");
#pragma unroll
            for (int bj = 0; bj < 2; ++bj) { xc[bj] = xn[bj]; gc[bj][0] = gn2[bj][0]; gc[bj][1] = gn2[bj][1]; } }
    }
};

__device__ __forceinline__ void fph_win(PArgs pa) {
    const Cx c = make_cx(pa);
    PlainSrc S{(const char*)HBUF(c), (const char*)(c.ws + WS_WIN), 2048, 2048, MTOT / 256, (NWIN + 2048) / 256, c.G, c.bid, g8::nig_inv((NWIN + 2048) / 256)};
    EpiWin E{(bf16*)(c.ws + WS_USB), (bf16*)(c.ws + WS_PROJ), (bf16*)(c.ws + WS_T1), (unsigned char*)(c.ws + WS_SG5Q), SGGQ(c)};
    g8::gemm256<EpiWin, PlainSrc, false>(pa.lds, S, E, 16, 1024, 1024);
}
__device__ __forceinline__ void fph_s5_e(PArgs pa) {
    const Cx c = make_cx(pa);
    BatchSrc S{(const char*)(c.ws + WS_USB), (const char*)(c.ws + WS_WE), 1024, 512, 9, c.G, c.bid};
    EpiS5E E{(bf16*)(c.ws + WS_EB)};
    g8::gemm256<EpiS5E, BatchSrc, false>(pa.lds, S, E, 4, 512, 256);
}
__device__ __forceinline__ void fph_s5_y(PArgs pa, int nbr) {
    const Cx c = make_cx(pa);
    BatchSrc S{(const char*)(c.ws + WS_USB), (const char*)(c.ws + WS_WY), 1024, 1024, (nbr + 255) / 256, c.G, c.bid};
    EpiS5Y E{(bf16*)(c.ws + WS_AB), nbr};
    g8::gemm256<EpiS5Y, BatchSrc, false>(pa.lds, S, E, 8, 512, 512);
}
__device__ __forceinline__ void fph_gates(PArgs pa, int M) {
    const Cx c = make_cx(pa);
    PlainSrc S{(const char*)(c.ws + WS_OB), (const char*)(c.ws + WS_WUP), 1024, 1024, M / 256, 4, c.G, c.bid, g8::nig_inv(4)};
    EpiBf16 E{(bf16*)(c.ws + WS_USB), 1024, 0};
    g8::gemm256<EpiBf16, PlainSrc, false>(pa.lds, S, E, 8, 512, 512);
}
__device__ __forceinline__ void fph_merge(PArgs pa, int M) {
    const Cx c = make_cx(pa);
    DualSrc S{(const char*)(c.ws + WS_AB), (const char*)(c.ws + WS_WA), (const char*)(c.ws + WS_WB), 1024, 1024, M / 256, 8, c.G, c.bid, g8::nig_inv(8)};
    EpiMerge E{(const unsigned char*)(c.ws + WS_SG5Q), SGGQ(c), (const bf16*)(c.ws + WS_USB), (bf16*)(c.ws + WS_PROJ)};
    g8::gemm256<EpiMerge, DualSrc, false>(pa.lds, S, E, 8, 512, 512);
}
__device__ __forceinline__ void fph_wout(PArgs pa, int l, int M) {
    const Cx c = make_cx(pa);
    PlainSrc S{(const char*)(c.ws + WS_PROJ), (const char*)(c.ws + WS_WOUT), 2048, 2048, M / 256, 4, c.G, c.bid, g8::nig_inv(4)};
    EpiWout E{c.in[0], c.in[2], LATB(c), (const float*)(c.ws + WS_MODS), l};
    g8::gemm256<EpiWout, PlainSrc, false>(pa.lds, S, E, 16, 1024, 1024);
}
__device__ __forceinline__ void moe_tiles_fast(const Cx& c, int l, LAS int* tb) {
    const unsigned* gcnt = (const unsigned*)(c.ws + WS_CTL + CTL_CNT_OFF) + l * 32;
    if (c.tid == 0) { int s = 0; for (int b = 0; b < 24; ++b) { tb[b] = s; const int cnt = (int)gcnt[b]; tb[32 + b] = cnt; s += (cnt + 255) / 256; } tb[24] = s; }
    __syncthreads();
    if (c.tid < tb[24]) { int bk = 0, tbase = 0, prev = tb[0]; for (int b = 0; b < 24; ++b) { const int nb = tb[b + 1]; if (prev <= c.tid && c.tid < nb) { bk = b; tbase = prev; } prev = nb; }
        tb[64 + c.tid] = bk | ((c.tid - tbase) << 8); }
    __syncthreads();
}
__device__ __forceinline__ void fph_moe(PArgs pa, int l) {
    const Cx c = make_cx(pa);
    LAS int* tb = (LAS int*)(pa.lds + LDS_MOE_TAB); moe_tiles_fast(c, l, tb);
    const int T = __builtin_amdgcn_readfirstlane(tb[24]);
    unsigned* ready = (unsigned*)(c.ws + WS_CTL + CTL_TILE_OFF) + (size_t)l * TILE_CAP * TILE_STRIDE;
    {
        Moe1Src S{(const char*)HBUF(c), xw_set(c, l), (const int*)(c.ws + WS_PERM), tb, T, c.G, c.bid, ready, (const float*)(c.ws + WS_PW)};
        EpiMoe1 E{(bf16*)(c.ws + WS_PROJ), (const LAS float*)(pa.lds + LDS_EPI_TAB)};
        g8::gemm256<EpiMoe1, Moe1Src, true>(pa.lds, S, E, 16, 1024, 1024);
    }
    __syncthreads();
    {
        const int k0 = ((c.bid - (T * 8) % c.G) % c.G + c.G) % c.G;
        Moe2Src S{(const char*)(c.ws + WS_PROJ), xw_set(c, l), tb, T, c.G, k0, ready, (const int*)(c.ws + WS_PERM)};
        EpiMoe2 E{LATB(c), (const float*)(c.ws + WS_MODS), (const LAS int*)(pa.lds + LDS_EPI_TAB), l};
        g8::gemm256<EpiMoe2, Moe2Src, false>(pa.lds, S, E, 8, 1024, 512);
    }
    __syncthreads();
    if (l == 0) ph_bg(pa, T * 12, BG_H, BG_K, true);
}

extern "C" __global__ void __launch_bounds__(NTHR, 2) mk_fwd(Args args) {
    extern __shared__ __attribute__((aligned(16))) unsigned char lds_raw[];
    PArgs pa; pa.out = args.out; pa.ws = args.ws; pa.lds = (LAS unsigned char*)lds_raw;
    volatile LAS unsigned* bst = (volatile LAS unsigned*)(lds_raw + LDS_BYTES - 16);
    if (threadIdx.x == 0) { bst[0] = 0u; bst[1] = 0u; bst[2] = 0u; bst[3] = 0u; }
    if (threadIdx.x < 33) ((LAS long long*)(lds_raw + LDS_TAB_OFF))[threadIdx.x] = (long long)((const char*)args.in[threadIdx.x] - (const char*)args.ws);
    __syncthreads();
    const int lo = args.ph_lo, hi = args.ph_hi;
    XcdBarrier bar; bar.bar = (unsigned*)(args.ws + WS_CTL); bar.x = 0; bar.st = bst;
    if (hi - lo > 1) bar = xcd_barrier_post((unsigned*)(args.ws + WS_CTL), bst);
#ifndef MK_ONLY
#define MK_ONLY -1
#endif
#define IN(k) ((MK_ONLY < 0 || ((k) == 0 ? 0 : ((k) == 23 ? 12 : ((k) - 1) % 11 + 1)) == MK_ONLY) && lo <= (k) && (k) < hi)
#define SEAM(k) do { if (IN((k) + 1)) xcd_barrier(bar); } while (0)
    if (IN(0)) { ph_mods(pa); __syncthreads(); ph_convert(pa); __syncthreads(); ph_s5prep(pa, 0, (int)blockIdx.x, (int)gridDim.x, 0, 256); SEAM(0); }
#define LAYER_BODY(l) { \
        const int base = 1 + 11 * (l); \
        const int M = (l == 0) ? MTOT : NLAT; \
        if (IN(base + 0)) { if (l != 0) { ph_convert1(pa); __syncthreads(); } ph_norm(pa, l, 0, MTOT); SEAM(base + 0); } \
        if (IN(base + 1)) { fph_win(pa); SEAM(base + 1); } \
        if (IN(base + 2)) { fph_s5_e(pa); __syncthreads(); ph_gla_kv(pa, l, true); SEAM(base + 2); } \
        if (IN(base + 3)) { ph_scan(pa); SEAM(base + 3); } \
        if (IN(base + 4)) { fph_s5_y(pa, l == 0 ? NBR : 2048); __syncthreads(); ph_gla_out(pa, l, l == 0 ? 0 : 2, l == 0); SEAM(base + 4); } \
        if (IN(base + 5)) { fph_gates(pa, M); if (l == 0) { ph_bg(pa, (M / 256) * 4, BG_X0, BG_F, false); const int ex_ = ((M / 256) * 4) % (int)gridDim.x, P_ = (int)gridDim.x - ex_; ph_s5prep(pa, 1, (int)blockIdx.x - ex_, P_, 0, P_ < 256 ? P_ : 256); } SEAM(base + 5); } \
        if (IN(base + 6)) { fph_merge(pa, M); if (l == 0) { ph_bg(pa, (M / 256) * 8, BG_F, BG_G, false); const int exF_ = ((M / 256) * 4) % (int)gridDim.x, PF_ = (int)gridDim.x - exF_, ex_ = ((M / 256) * 8) % (int)gridDim.x, P_ = (int)gridDim.x - ex_; ph_s5prep(pa, 1, (int)blockIdx.x - ex_, P_, PF_ < 256 ? PF_ : 256, 256); } SEAM(base + 6); } \
        if (IN(base + 7)) { fph_wout(pa, l, M); if (l == 0) ph_bg(pa, (M / 256) * 4, BG_G, BG_H, false); SEAM(base + 7); } \
        if (IN(base + 8)) { ph_norm(pa, l, 1, M); SEAM(base + 8); } \
        if (IN(base + 9)) { fph_moe(pa, l); SEAM(base + 9); } \
    }
#pragma unroll 1
    for (int l = 0; l < 2; ++l) {
        PArgs pa0 = pa; { unsigned long long z0 = 0, z1 = 0; unsigned z2 = 0; asm volatile("" : "+s"(z0), "+s"(z1), "+s"(z2)); pa0.out = pa.out + z0; pa0.ws = pa.ws + z1; pa0.lds = pa.lds + z2; }
        const PArgs pa = pa0;
        LAYER_BODY(l)
    }
#undef LAYER_BODY
    if (IN(23)) ph_final(pa);
#undef IN
#undef SEAM
}

}

extern "C" void kernel_launch(void* const* d_in, const int* in_sizes, int n_in, void* d_out, int out_size, void* d_ws, size_t ws_size, hipStream_t stream) {
    static int grid = 0;
    if (grid == 0) {
        if (n_in != 33 || out_size != NLAT * D || ws_size < WS_END) { fprintf(stderr, "kernel_launch: unexpected shapes (n_in %d out %d ws %zu need %zu)\n", n_in, out_size, ws_size, (size_t)WS_END); grid = -1; return; }
        int dev = 0, cus = 0, per_cu = 0;
        if (hipGetDevice(&dev) != hipSuccess || hipDeviceGetAttribute(&cus, hipDeviceAttributeMultiprocessorCount, dev) != hipSuccess) { grid = -1; return; }
        if (hipFuncSetAttribute((const void*)mk_fwd, hipFuncAttributeMaxDynamicSharedMemorySize, LDS_BYTES) != hipSuccess) { fprintf(stderr, "kernel_launch: hipFuncSetAttribute failed\n"); grid = -1; return; }
        if (hipOccupancyMaxActiveBlocksPerMultiprocessor(&per_cu, (const void*)mk_fwd, NTHR, LDS_BYTES) != hipSuccess || per_cu < 1) { fprintf(stderr, "kernel_launch: occupancy query says %d\n", per_cu); }
        (void)hipGetLastError();
        grid = cus;
    }
    if (grid < 0) return;
    (void)hipMemsetAsync((char*)d_ws + WS_CTL, 0, CTL_BYTES, stream);
    Args a{};
    for (int i = 0; i < 33; ++i) a.in[i] = (const float*)d_in[i];
    a.out = (float*)d_out; a.ws = (unsigned char*)d_ws;
#if MK_ONE_LAUNCH
    a.ph_lo = 0; a.ph_hi = NPHASE;
    hipLaunchKernelGGL(mk_fwd, dim3(grid), dim3(NTHR), LDS_BYTES, stream, a);
#else
    for (int p = 0; p < NPHASE; ++p) { a.ph_lo = p; a.ph_hi = p + 1; hipLaunchKernelGGL(mk_fwd, dim3(grid), dim3(NTHR), LDS_BYTES, stream, a); }
#endif
}
```

```cpp
#include <hip/hip_runtime.h>
#include <cstdio>
#include <cstdint>

#define G8_ORIGMAP 0
#define DBG_CHECK 0
#ifndef FAST_MASK
#define FAST_MASK 0xff
#endif
#ifndef MK_ONE_LAUNCH
#define MK_ONE_LAUNCH 1
#endif

namespace {

typedef unsigned short bf16;
typedef short bf16x8 __attribute__((ext_vector_type(8)));
typedef float f32x4 __attribute__((ext_vector_type(4)));
#define LAS __attribute__((address_space(3)))

constexpr int D = 1024, NB_ = 4, SEQ = 8192, CTXL = 256;
constexpr int NLAT = NB_ * SEQ;
constexpr int NCTX = NB_ * CTXL;
constexpr int MTOT = NLAT + NCTX;
constexpr int NTHR = 512;
constexpr int LDS_BYTES = 147456;
constexpr int NPHASE = 24;
constexpr int NWIN = 2304;
constexpr int BRP = 2304;
constexpr int NBR = 2112;
constexpr int NPC = 66;
constexpr int CAP = MTOT;
constexpr int TM = 128;

constexpr int PQ = 0, PK = 256, PV = 512, PR = 1024, PZF = 1536, PZB = 1792;

constexpr size_t al256(size_t x) { return (x + 255) & ~(size_t)255; }
constexpr size_t WS_CTL = 0;
constexpr size_t CTL_BYTES = 65536;
constexpr size_t CTL_CNT_OFF = 16384;
constexpr size_t CTL_TILE_OFF = 20480;
constexpr int TILE_CAP = 160, TILE_STRIDE = 32;
static_assert(CTL_TILE_OFF + (size_t)2 * TILE_CAP * TILE_STRIDE * 4 <= CTL_BYTES, "control block");
constexpr size_t WS_MODS = WS_CTL + CTL_BYTES;
constexpr size_t WS_S5AT = WS_MODS + al256(2 * 5 * 6144 * 4);
constexpr size_t WS_WIN = 1048576;
constexpr size_t WS_WG = WS_WIN + (size_t)NWIN * 1024 * 2;
constexpr size_t WS_WA = WS_WG + (size_t)2048 * 1024 * 2;
constexpr size_t WS_WB = WS_WA + (size_t)1024 * 512 * 2;
constexpr size_t WS_WUP = WS_WB + (size_t)1024 * 512 * 2;
constexpr size_t WS_WOUT = WS_WUP + (size_t)1024 * 512 * 2;
constexpr size_t WS_WEG = WS_WOUT + (size_t)1024 * 1024 * 2;
constexpr size_t WS_WEU = WS_WEG + (size_t)16 * 512 * 1024 * 2;
constexpr size_t WS_WED = WS_WEU + (size_t)16 * 512 * 1024 * 2;
constexpr size_t WS_WE = WS_WED + (size_t)16 * 512 * 1024 * 2;
constexpr size_t WS_WY = WS_WE + (size_t)32 * 256 * 256 * 2;
constexpr size_t WS_H = WS_WY + (size_t)32 * 256 * 512 * 2;
constexpr size_t WS_PROJ = WS_H + (size_t)MTOT * D * 2;
constexpr size_t WS_USB = WS_PROJ + (size_t)MTOT * 2048 * 2;
constexpr size_t WS_EB = WS_USB + (size_t)32 * BRP * 512 * 2;
constexpr size_t WS_KVB = WS_EB + (size_t)32 * BRP * 256 * 2;
constexpr size_t WS_AB = WS_EB;
constexpr size_t WS_OB = WS_AB + (size_t)MTOT * 512 * 2;
constexpr size_t WS_DEC = WS_KVB + (size_t)4 * 2 * NPC * 4 * 8192 * 2;
constexpr size_t WS_SST = WS_DEC + al256((size_t)4 * 2 * NPC * 4 * 64 * 4);
constexpr size_t WS_PERM = WS_SST + (size_t)4 * 2 * NPC * 4 * 8192 * 2;
constexpr size_t WS_PW = WS_PERM + (size_t)24 * CAP * 4;
constexpr size_t WS_T1 = WS_PW + (size_t)24 * CAP * 8;
constexpr size_t WS_SG5Q = WS_T1 + (size_t)MTOT * 32 * 2;
constexpr size_t WS_X1 = WS_SG5Q + (size_t)MTOT * 1024;
constexpr int X1_SPLIT = 29;
constexpr size_t X1_OUT_OFF = (size_t)MTOT * 2048 + (size_t)MTOT * 1024;
constexpr size_t WS_END = WS_X1 + (size_t)(48 - X1_SPLIT) * 1048576;
static_assert(X1_OUT_OFF + (size_t)X1_SPLIT * 1048576 <= (size_t)NLAT * D * 4, "d_out tail");
static_assert(WS_OB + (size_t)MTOT * 512 * 2 <= WS_DEC, "AB/OB alias region");
static_assert(WS_S5AT + 2 * 32 * 64 * 8 <= WS_WIN, "small region");
static_assert(WS_END <= (size_t)512 * 1024 * 1024, "workspace");

#define XB_TMO      128
#define XB_XCNT(j)  (256  + 64 * (j))
#define XB_XSUB(j)  (1280 + 64 * (j))
#define XB_XGEN(j)  (2304 + 64 * (j))
#define XB_TOP      3328
#define XB_TOPGEN   3392
#define XCD_BAR_WORDS 3456
#define XB_SPIN_CAP (1u << 18)

__device__ __forceinline__ unsigned xb_ld(unsigned* p)              { return __hip_atomic_load(p, __ATOMIC_RELAXED, __HIP_MEMORY_SCOPE_AGENT); }
__device__ __forceinline__ unsigned xb_add(unsigned* p, unsigned v) { return __hip_atomic_fetch_add(p, v, __ATOMIC_RELAXED, __HIP_MEMORY_SCOPE_AGENT); }
__device__ __forceinline__ unsigned xb_xcc_id() { return (unsigned)__builtin_amdgcn_s_getreg((3 << 11) | 20) & 0xFu; }
#define XB_SPIN(cond, bar) do { unsigned _sp = 0; while (cond) { __builtin_amdgcn_s_sleep(1); \
    if ((++_sp & 255u) == 0u) { if (xb_ld(&(bar)[XB_TMO])) break; if (_sp > XB_SPIN_CAP) { atomicAdd(&(bar)[XB_TMO], 1u); break; } } } } while (0)

struct XcdBarrier { unsigned* bar; unsigned x; volatile LAS unsigned* st; };

__device__ __forceinline__ XcdBarrier xcd_barrier_post(unsigned* bar, volatile LAS unsigned* st) {
    XcdBarrier b; b.bar = bar; b.x = xb_xcc_id(); b.st = st;
    if (threadIdx.x == 0) (void)xb_add(&bar[XB_XCNT(b.x)], 1u);
    return b;
}
__device__ __forceinline__ void xcd_barrier_complete(unsigned* bar, unsigned x, unsigned& nloc, unsigned& nx) {
    const unsigned G = gridDim.x * gridDim.y * gridDim.z;
    unsigned sum, cnt, mine, sp = 0u;
    for (;;) {
        sum = 0u; cnt = 0u; mine = 0u;
#pragma unroll
        for (unsigned j = 0; j < 16; ++j) { const unsigned c = xb_ld(&bar[XB_XCNT(j)]); sum += c; cnt += (c > 0u) ? 1u : 0u; mine = (j == x) ? c : mine; }
        if (sum == G) break;
        __builtin_amdgcn_s_sleep(1);
        if ((++sp & 255u) == 0u) { if (xb_ld(&bar[XB_TMO])) break; if (sp > XB_SPIN_CAP) { atomicAdd(&bar[XB_TMO], 1u); break; } }
    }
    nloc = mine > 0u ? mine : 1u; nx = cnt > 0u ? cnt : 1u;
}
__device__ __forceinline__ void xcd_barrier(const XcdBarrier& b) {
    asm volatile("s_waitcnt vmcnt(0)" ::: "memory");
    __syncthreads();
    if (threadIdx.x == 0) {
        unsigned* bar = b.bar;
        __builtin_amdgcn_s_waitcnt(0);
        unsigned nloc = b.st[0], nx = b.st[1];
        if (nloc == 0u) { xcd_barrier_complete(bar, b.x, nloc, nx); b.st[0] = nloc; b.st[1] = nx; }
        const unsigned old = xb_add(&bar[XB_XSUB(b.x)], 1u);
        const unsigned gen = old / nloc;
        if (old + 1u == (gen + 1u) * nloc) {
            __builtin_amdgcn_fence(__ATOMIC_RELEASE, "agent");
            asm volatile("s_waitcnt vmcnt(0)" ::: "memory");
            const unsigned og = xb_add(&bar[XB_TOP], 1u);
            const unsigned tg = og / nx;
            if (og + 1u == (tg + 1u) * nx) xb_add(&bar[XB_TOPGEN], 1u);
            else XB_SPIN(xb_ld(&bar[XB_TOPGEN]) == tg, bar);
            __builtin_amdgcn_fence(__ATOMIC_ACQUIRE, "agent");
            xb_add(&bar[XB_XGEN(b.x)], 1u);
            asm volatile("s_waitcnt vmcnt(0)" ::: "memory");
        } else {
            XB_SPIN(xb_ld(&bar[XB_XGEN(b.x)]) == gen, bar);
            __builtin_amdgcn_fence(__ATOMIC_ACQUIRE, "agent");
            asm volatile("s_waitcnt vmcnt(0)" ::: "memory");
        }
    }
    __syncthreads();
}

typedef __bf16 bf16x2_t __attribute__((ext_vector_type(2)));
__device__ __forceinline__ unsigned cvt_pk_bf16(float lo, float hi) { bf16x2_t v; v[0] = (__bf16)lo; v[1] = (__bf16)hi; return __builtin_bit_cast(unsigned, v); }
__device__ __forceinline__ bf16 f2bf(float f) { return (bf16)(cvt_pk_bf16(f, 0.f) & 0xffffu); }
__device__ __forceinline__ float bf2f(bf16 b) { return __uint_as_float(((unsigned)b) << 16); }
__device__ __forceinline__ float bflo(unsigned w) { return __uint_as_float(w << 16); }
__device__ __forceinline__ float bfhi(unsigned w) { return __uint_as_float(w & 0xffff0000u); }
__device__ __forceinline__ float sigmoidf_(float x) { return __builtin_amdgcn_rcpf(1.0f + __expf(-x)); }
__device__ __forceinline__ float siluf_(float x) { return x * __builtin_amdgcn_rcpf(1.0f + __expf(-x)); }
__device__ __forceinline__ float gelu_tanh(float x) { const float u = 0.7978845608028654f * (x + 0.044715f * x * x * x); const float t = 1.0f - 2.0f * __builtin_amdgcn_rcpf(1.0f + __expf(2.0f * u)); return 0.5f * x * (1.0f + t); }
__device__ __forceinline__ float logsigmoidf_(float x) { return fminf(x, 0.f) - log1pf(__expf(-fabsf(x))); }
__device__ __forceinline__ float wave_sum(float v) {
    const int z = 0;
    v += __builtin_bit_cast(float, __builtin_amdgcn_update_dpp(z, __builtin_bit_cast(int, v), 0xB1, 0xf, 0xf, true));
    v += __builtin_bit_cast(float, __builtin_amdgcn_update_dpp(z, __builtin_bit_cast(int, v), 0x4E, 0xf, 0xf, true));
    v += __builtin_bit_cast(float, __builtin_amdgcn_update_dpp(z, __builtin_bit_cast(int, v), 0x141, 0xf, 0xf, true));
    v += __builtin_bit_cast(float, __builtin_amdgcn_update_dpp(z, __builtin_bit_cast(int, v), 0x140, 0xf, 0xf, true));
    v += __builtin_bit_cast(float, __builtin_amdgcn_update_dpp(z, __builtin_bit_cast(int, v), 0x142, 0xa, 0xf, false));
    v += __builtin_bit_cast(float, __builtin_amdgcn_update_dpp(z, __builtin_bit_cast(int, v), 0x143, 0xc, 0xf, false));
    return __builtin_bit_cast(float, __builtin_amdgcn_readlane(__builtin_bit_cast(int, v), 63));
}
__device__ __forceinline__ void store_bf16x4(bf16* p, f32x4 v) { uint2 w; w.x = cvt_pk_bf16(v[0], v[1]); w.y = cvt_pk_bf16(v[2], v[3]); *(uint2*)p = w; }


__device__ __forceinline__ double my_exp(double x) {
    unsigned long long z_ = 0; asm volatile("" : "+s"(z_));
    const double k = rint(x * __longlong_as_double(0x3FF71547652B82FEull ^ z_));
    const double r = (x - k * __longlong_as_double(0x3FE62E42FEE00000ull ^ z_)) - k * __longlong_as_double(0x3DEA39EF35793C76ull ^ z_);
    double t = 1.0, sum = 1.0;
#pragma unroll 1
    for (int i = 1; i <= 16; ++i) { t = t * r / (double)i; sum += t; }
    const long long bits = ((long long)k + 1023ll) << 52;
    return sum * __longlong_as_double(bits);
}
__device__ __forceinline__ void my_sincos(double x, double& s, double& c) {
    unsigned long long z_ = 0; asm volatile("" : "+s"(z_));
    const double k = rint(x * __longlong_as_double(0x3FE45F306DC9C883ull ^ z_));
    const double r = (x - k * __longlong_as_double(0x3FF921FB54400000ull ^ z_)) - k * __longlong_as_double(0x3DD0B4611A626331ull ^ z_);
    const double z = r * r;
    double ts = r, ss = r, tc = 1.0, sc = 1.0;
#pragma unroll 1
    for (int i = 1; i <= 10; ++i) { ts = -ts * z / (double)((2 * i) * (2 * i + 1)); ss += ts; tc = -tc * z / (double)((2 * i - 1) * (2 * i)); sc += tc; }
    const int q = ((int)k) & 3;
    s = (q == 0) ? ss : (q == 1) ? sc : (q == 2) ? -ss : -sc;
    c = (q == 0) ? sc : (q == 1) ? -ss : (q == 2) ? -sc : ss;
}

struct Args { const float* in[33]; float* out; unsigned char* ws; int ph_lo, ph_hi; };

struct InTab { const long long* p; unsigned char* base; __device__ __forceinline__ const float* operator[](int k) const { return (const float*)(base + p[k]); } };
struct Cx {
    InTab in; float* out; unsigned char* ws; unsigned char* lds;
    int tid, lane, wid, G, bid;
    int vG, vbid;
};
struct PArgs { float* out; unsigned char* ws; LAS unsigned char* lds; };
constexpr int LDS_TAB_OFF = LDS_BYTES - 16 - 272;
__device__ __forceinline__ Cx make_cx(const PArgs& pa) {
    unsigned long long zo_ = 0, zw_ = 0; asm volatile("" : "+s"(zo_), "+s"(zw_));
    float* o_ = (float*)((unsigned char*)pa.out + zo_); unsigned char* w_ = pa.ws + zw_;
    Cx c; c.lds = (unsigned char*)pa.lds; c.in.p = (const long long*)(c.lds + LDS_TAB_OFF); c.out = o_; c.ws = w_; c.in.base = w_;
    { int t_ = threadIdx.x; asm volatile("" : "+v"(t_)); c.tid = t_; } c.lane = c.tid & 63; c.wid = __builtin_amdgcn_readfirstlane(c.tid >> 6); c.G = gridDim.x; c.bid = blockIdx.x;
    c.vG = c.G; c.vbid = c.bid;
    return c;
}

__device__ __forceinline__ int mod_index(int r) { return r < NLAT ? (r >> 13) : 4; }
#define LATB(c) ((bf16*)((c).ws + WS_H))
#define HBUF(c) ((bf16*)((c).out))
#define SGGQ(c) ((unsigned char*)((c).out) + (size_t)MTOT * 2048)
__device__ __forceinline__ const float* in_row_f32(const Cx& c, int r) { return r < NLAT ? c.in[0] + (size_t)r * D : c.in[2] + (size_t)(r - NLAT) * D; }
__device__ __forceinline__ const float* mods_ptr(const Cx& c, int layer, int mi, int which) { return (const float*)(c.ws + WS_MODS) + ((size_t)(layer * 5 + mi) * 6144 + which * 1024); }

namespace g8 {
constexpr int BM = 256, BK = 64, HALF = 128, HTB = HALF * BK * 2, STAGE_BYTES = 8 * HTB;
__device__ __forceinline__ int lds_byte(int r, int c) { const int st = (r >> 4) * 2 + (c >> 5), rr = r & 15, cc = c & 31, ob = rr * 64 + cc * 2; return st * 1024 + (ob ^ (((ob >> 9) & 1) << 5)); }
__device__ __forceinline__ void stage_rc(int b, int& R, int& C) { const int st = b / 1024, sb = b % 1024, swz = sb ^ (((sb >> 9) & 1) << 5); R = (st >> 1) * 16 + swz / 64; C = (st & 1) * 32 + (swz % 64) / 2; }
__device__ __forceinline__ int perm32(int rho) { const int n = rho >> 4, i = rho & 15; return 8 * (i >> 2) + 4 * n + (i & 3); }

struct GUnit { const char* A0; const char* A1; const char* B0; const char* B1; int pm, pn, x0, x1, cont, par; };

__device__ __forceinline__ unsigned nig_inv(int nN) { return ((1u << 22) + 8u * (unsigned)nN - 1u) / (8u * (unsigned)nN); }
__device__ __forceinline__ bool tile_order(int L, int nM, int nN, unsigned inv, int& pm, int& pn) {
    const int nwg = nM * nN; if (L >= nwg) return false;
    int wgid = L; { const int q = nwg >> 3, r = nwg & 7, xcd = wgid & 7, off = wgid >> 3; wgid = (xcd < r ? xcd * (q + 1) : r * (q + 1) + (xcd - r) * q) + off; }
    const int nig = 8 * nN, gid = (int)(((unsigned)wgid * inv) >> 22), fm = gid * 8, gsz = (nM - fm) < 8 ? (nM - fm) : 8, w = wgid - gid * nig;
    if (gsz == 8) { pm = fm + (w & 7); pn = w >> 3; } else { pm = fm + (w % gsz); pn = w / gsz; }
    return true;
}

template <class Epi, class Src, bool GATHER>
__device__ __forceinline__ void gemm256(LAS unsigned char* lds, const Src& S, const Epi& E, const int nt, const int lda, const int ldb) {
    int tid_ = threadIdx.x; asm volatile("" : "+v"(tid_));
    const int tid = tid_, wid = __builtin_amdgcn_readfirstlane(tid >> 6), lane = tid & 63, wr = wid >> 2, wc = wid & 3, fr = lane & 15, fq = lane >> 4;
#ifndef G8_ORIGMAP
#define G8_ORIGMAP 0
#endif
#if G8_ORIGMAP
    unsigned voffA[2][2], voffB[2]; int sR = 0, sC = 0;
#pragma unroll
    for (int i = 0; i < 2; ++i) { int R, C; stage_rc(tid * 16 + i * 8192, R, C); const int Rb = Epi::PERM ? ((R & ~31) + perm32(R & 31)) : R;
        voffA[0][i] = voffA[1][i] = (unsigned)(R * lda + C) * 2u; voffB[i] = (unsigned)(Rb * ldb + C) * 2u; }
    const unsigned ldsw = (unsigned)wid * 1024u;
#else
    unsigned voffA[2], voffB; int sR, sC;
    { stage_rc(wid * 2048 + lane * 16, sR, sC); const int Rb = Epi::PERM ? ((sR & ~31) + perm32(sR & 31)) : sR;
      voffA[0] = voffA[1] = (unsigned)(sR * lda + sC) * 2u; voffB = (unsigned)(Rb * ldb + sC) * 2u; }
    const unsigned ldsw = (unsigned)wid * 2048u;
#endif
    const int aoff = lds_byte(wr * 64 + fr, fq * 8), boff = lds_byte(wc * 32 + fr, fq * 8);
#define G8_SA(b, h) (((b) * 2 + (h)) * HTB)
#define G8_SB(b, h) ((4 + (b) * 2 + (h)) * HTB)
#if G8_ORIGMAP
#define G8_STAGE(bufoff, gbase, voff) do { _Pragma("unroll") for (int _i = 0; _i < 2; ++_i) \
        __builtin_amdgcn_global_load_lds((const unsigned*)((const char*)(gbase) + (voff)[_i]), (LAS unsigned*)(lds + (bufoff) + ldsw + _i * 8192), 16, 0, 0); } while (0)
#else
#define G8_STAGE(bufoff, gbase, voff) do { _Pragma("unroll") for (int _i = 0; _i < 2; ++_i) \
        __builtin_amdgcn_global_load_lds((const unsigned*)((const char*)(gbase) + (voff) + _i * 64), (LAS unsigned*)(lds + (bufoff) + ldsw + _i * 1024), 16, 0, 0); } while (0)
#endif
#define G8_LDA(dst, b, h) do { _Pragma("unroll") for (int m = 0; m < 4; ++m) _Pragma("unroll") for (int k = 0; k < 2; ++k) dst[m][k] = *(const LAS bf16x8*)(lds + G8_SA(b, h) + aoff + m * 2048 + k * 1024); } while (0)
#define G8_LDB(dst, b, h) do { _Pragma("unroll") for (int n = 0; n < 2; ++n) _Pragma("unroll") for (int k = 0; k < 2; ++k) dst[n][k] = *(const LAS bf16x8*)(lds + G8_SB(b, h) + boff + n * 2048 + k * 1024); } while (0)
#define G8_MMA(ai, bj, At, Bt) do { __builtin_amdgcn_s_setprio(1); _Pragma("unroll") for (int m = 0; m < 4; ++m) _Pragma("unroll") for (int n = 0; n < 2; ++n) _Pragma("unroll") for (int k = 0; k < 2; ++k) \
        acc[ai][bj][m][n] = __builtin_amdgcn_mfma_f32_16x16x32_bf16(Bt[n][k], At[m][k], acc[ai][bj][m][n], 0, 0, 0); __builtin_amdgcn_s_setprio(0); } while (0)
#ifndef G8_DRAIN
#define G8_DRAIN 0
#endif
#if G8_DRAIN
#define G8_WAIT_V(n) asm volatile("s_waitcnt vmcnt(0)" ::: "memory")
#else
#define G8_WAIT_V(n) asm volatile("s_waitcnt vmcnt(" #n ")" ::: "memory")
#endif
#define G8_WAIT_L(n) asm volatile("s_waitcnt lgkmcnt(" #n ")" ::: "memory")
#define G8_BAR __builtin_amdgcn_s_barrier()
#define G8_SCHED __builtin_amdgcn_sched_barrier(0)
#if G8_ORIGMAP
#define G8_GOFF(u) do { } while (0)
#else
#define G8_GOFF(u) do { if constexpr (GATHER) { _Pragma("unroll") for (int _h = 0; _h < 2; ++_h) voffA[_h] = S.row_off(u, _h * 128 + sR) + (unsigned)sC * 2u; } } while (0)
#endif
    GUnit cur, nxt; int ui = 0;
    if (!S.next(0, cur)) return;
    cur.par = 0;
    S.a_ready(cur);
    G8_GOFF(cur);
    f32x4 acc[2][2][4][2];
#pragma unroll
    for (int a = 0; a < 2; ++a)
#pragma unroll
        for (int b = 0; b < 2; ++b)
#pragma unroll
            for (int m = 0; m < 4; ++m)
#pragma unroll
                for (int n = 0; n < 2; ++n) acc[a][b][m][n] = (f32x4){0.f, 0.f, 0.f, 0.f};
    bf16x8 At[4][2], B0[2][2], B1[2][2];
    G8_STAGE(G8_SB(0, 0), cur.B0, voffB); G8_STAGE(G8_SA(0, 0), cur.A0, voffA[0]); G8_STAGE(G8_SB(0, 1), cur.B1, voffB); G8_STAGE(G8_SA(0, 1), cur.A1, voffA[1]);
    if (wr == 1) G8_BAR;
    G8_WAIT_V(4); G8_BAR;
    G8_STAGE(G8_SB(1, 0), cur.B0 + 128, voffB); G8_STAGE(G8_SA(1, 0), cur.A0 + 128, voffA[0]); G8_STAGE(G8_SB(1, 1), cur.B1 + 128, voffB);
    G8_WAIT_V(6); G8_BAR;
    for (;;) {
        const bool has_next = S.next(ui + 1, nxt);
        if (!has_next) nxt = cur;
        nxt.par = (ui + 1) & 1;
        S.prefetch(cur, lds, wid, lane);
        unsigned nvoff[2] = {0u, 0u};
        if constexpr (GATHER) { _Pragma("unroll") for (int _h = 0; _h < 2; ++_h) nvoff[_h] = S.row_off(nxt, _h * 128 + sR) + (unsigned)sC * 2u; }
        for (int t = 0; t < nt; t += 2) {
            const bool last = (t == nt - 2);
            if (last && has_next) S.a_ready(nxt);
            const char* a0_2 = last ? nxt.A0 : cur.A0 + (size_t)(t + 2) * 128; const char* a1_2 = last ? nxt.A1 : cur.A1 + (size_t)(t + 2) * 128;
            const char* b0_2 = last ? nxt.B0 : cur.B0 + (size_t)(t + 2) * 128; const char* b1_2 = last ? nxt.B1 : cur.B1 + (size_t)(t + 2) * 128;
            G8_LDB(B0, 0, 0); G8_SCHED; G8_LDA(At, 0, 0); G8_STAGE(G8_SA(1, 1), cur.A1 + (size_t)(t + 1) * 128, voffA[1]);
            G8_WAIT_L(8); G8_BAR; G8_WAIT_L(0); G8_MMA(0, 0, At, B0); G8_BAR; G8_SCHED;
            if (GATHER && last) { voffA[0] = nvoff[0]; voffA[1] = nvoff[1]; }
            G8_LDB(B1, 0, 1); G8_STAGE(G8_SB(0, 0), b0_2, voffB);
            G8_BAR; G8_WAIT_L(0); G8_MMA(0, 1, At, B1); G8_BAR;
            G8_LDA(At, 0, 1); G8_STAGE(G8_SA(0, 0), a0_2, voffA[0]);
            G8_BAR; G8_WAIT_L(0); G8_MMA(1, 0, At, B0); G8_BAR; G8_SCHED;
            G8_STAGE(G8_SB(0, 1), b1_2, voffB);
            G8_WAIT_V(6); G8_BAR; G8_MMA(1, 1, At, B1); G8_BAR;
            G8_LDB(B0, 1, 0); G8_SCHED; G8_LDA(At, 1, 0); G8_STAGE(G8_SA(0, 1), a1_2, voffA[1]);
            G8_WAIT_L(8); G8_BAR; G8_WAIT_L(0); G8_MMA(0, 0, At, B0); G8_BAR; G8_SCHED;
            G8_LDB(B1, 1, 1); G8_STAGE(G8_SB(1, 0), b0_2 + 128, voffB);
            G8_BAR; G8_WAIT_L(0); G8_MMA(0, 1, At, B1); G8_BAR;
            G8_LDA(At, 1, 1); G8_STAGE(G8_SA(1, 0), a0_2 + 128, voffA[0]);
            G8_BAR; G8_WAIT_L(0); G8_MMA(1, 0, At, B0); G8_BAR; G8_SCHED;
            G8_STAGE(G8_SB(1, 1), b1_2 + 128, voffB);
            G8_WAIT_V(6); G8_BAR; G8_MMA(1, 1, At, B1); G8_BAR;
        }
        if (!cur.cont) {
            E(acc, cur, wr, wc, fr, fq);
            S.done(cur);
            if (has_next) {
#pragma unroll
                for (int a = 0; a < 2; ++a)
#pragma unroll
                    for (int b = 0; b < 2; ++b)
#pragma unroll
                        for (int m = 0; m < 4; ++m)
#pragma unroll
                            for (int n = 0; n < 2; ++n) acc[a][b][m][n] = (f32x4){0.f, 0.f, 0.f, 0.f};
            }
        }
        if (!has_next) break;
        cur = nxt; ++ui;
    }
    G8_WAIT_V(0);
    if (wr == 0) G8_BAR;
    G8_BAR;
#undef G8_SA
#undef G8_SB
#undef G8_STAGE
#undef G8_LDA
#undef G8_LDB
#undef G8_MMA
#undef G8_WAIT_V
#undef G8_WAIT_L
#undef G8_BAR
#undef G8_SCHED
#undef G8_GOFF
}
}

__device__ __forceinline__ void ph_mods(PArgs pa) {
    const Cx c = make_cx(pa);
    float* sl = (float*)c.lds;
    for (int i = c.tid; i < 5 * 1024; i += NTHR) { const int v = i >> 10, k = i & 1023; const float x = v < 4 ? c.in[1][v * 1024 + k] : c.in[3][k]; sl[i] = siluf_(x); }
    __syncthreads();
    float* red = sl + 5 * 1024;
    for (int unit = c.bid; unit < 2 * 96; unit += c.G) {
        const int l = unit / 96, n0 = (unit % 96) * 64, col = c.tid & 63, ks = c.tid >> 6;
        const float* w = c.in[4] + ((size_t)l * 1024 + ks * 128) * 6144 + n0 + col;
        float a[5] = {0.f, 0.f, 0.f, 0.f, 0.f};
#pragma unroll 8
        for (int k = 0; k < 128; ++k) { const float wv = w[(size_t)k * 6144];
#pragma unroll
            for (int v = 0; v < 5; ++v) a[v] += sl[v * 1024 + ks * 128 + k] * wv; }
#pragma unroll
        for (int v = 0; v < 5; ++v) red[(ks * 5 + v) * 64 + col] = a[v];
        __syncthreads();
        if (c.tid < 320) { const int v = c.tid >> 6, cc = c.tid & 63; float s = 0.f;
#pragma unroll
            for (int q = 0; q < 8; ++q) s += red[(q * 5 + v) * 64 + cc];
            ((float*)(c.ws + WS_MODS))[(size_t)(l * 5 + v) * 6144 + n0 + cc] = s + c.in[5][l * 6144 + n0 + cc]; }
        __syncthreads();
    }
}

struct XW { const char* a; const char* b; int split; };
__device__ __forceinline__ XW xw_set(const Cx& c, int set) {
    XW x; if (set == 0) { x.a = (const char*)(c.ws + WS_WEG); x.b = x.a; x.split = 64; } else { x.a = (const char*)c.out + X1_OUT_OFF; x.b = (const char*)(c.ws + WS_X1); x.split = X1_SPLIT; } return x; }
__device__ __forceinline__ const char* xw_ptr(const XW& x, int m) { return m < x.split ? x.a + ((size_t)m << 20) : x.b + ((size_t)(m - x.split) << 20); }

__device__ __forceinline__ void cvt_T(const Cx& c, int p, int P, const float* src, int ldsrc, size_t src_batch, int K, int N, bf16* dstA, bf16* dstB, int mb, int split, int ldd, int nbatch,
                                      int sc_lo, int sc_hi, float scale, int& tile_off, int glo, int ghi) {
    float* tl = (float*)c.lds;
    const int tk = K / 128, tn = N / 64, per = tk * tn, total = per * nbatch;
    const int a = (glo - tile_off) > 0 ? (glo - tile_off) : 0, b = (ghi - tile_off) < total ? (ghi - tile_off) : total;
    const int goff = tile_off + a - glo;
    tile_off += total;
    if (p < 0 || a >= b) return;
    const int t0 = a + ((p - goff % P) + P) % P;
    const int nn = c.tid & 63, k0 = c.tid >> 6;
    const int kp = (c.tid & 63) * 2, n0 = c.tid >> 6;
    float ta[16], tb2[16];
    auto issue = [&](int t) {
        const int tA = t < b ? t : (b - 1), tBq = (t + P) < b ? (t + P) : tA;
        const int biA = tA / per, rA = tA % per, ktA = rA / tn, ntA = rA % tn, biB = tBq / per, rB = tBq % per, ktB = rB / tn, ntB = rB % tn;
        const float* sA = src + (size_t)biA * src_batch + (size_t)(ktA * 128) * ldsrc + ntA * 64;
        const float* sB = src + (size_t)biB * src_batch + (size_t)(ktB * 128) * ldsrc + ntB * 64;
#pragma unroll
        for (int j = 0; j < 16; ++j) ta[j] = sA[(size_t)(k0 + 8 * j) * ldsrc + nn];
#pragma unroll
        for (int j = 0; j < 16; ++j) tb2[j] = sB[(size_t)(k0 + 8 * j) * ldsrc + nn];
    };
    if (t0 < b) issue(t0);
    for (int t = t0; t < b; t += 2 * P) {
        const int tB = t + P; const bool hasB = tB < b;
        const int biA = t / per, rA = t % per, ktA = rA / tn, ntA = rA % tn;
        const int tBc = hasB ? tB : t; const int biB = tBc / per, rB = tBc % per, ktB = rB / tn, ntB = rB % tn;
#pragma unroll
        for (int j = 0; j < 16; ++j) { tl[(k0 + 8 * j) * 65 + nn] = ta[j]; tl[8320 + (k0 + 8 * j) * 65 + nn] = tb2[j]; }
        asm volatile("s_waitcnt lgkmcnt(0)" ::: "memory"); __builtin_amdgcn_s_barrier();
        if (t + 2 * P < b) issue(t + 2 * P);
        const int mA = mb + biA, mB = mb + biB;
        bf16* dA = (mA < split ? dstA + ((size_t)mA << 19) : dstB + ((size_t)(mA - split) << 19)) + (size_t)(ntA * 64) * ldd + ktA * 128;
#pragma unroll
        for (int j = 0; j < 8; ++j) { const int n2 = n0 + 8 * j; const int ng = ntA * 64 + n2; const float f = (ng >= sc_lo && ng < sc_hi) ? scale : 1.0f;
            *(unsigned*)(dA + (size_t)n2 * ldd + kp) = cvt_pk_bf16(tl[kp * 65 + n2] * f, tl[(kp + 1) * 65 + n2] * f); }
        if (hasB) { bf16* dB = (mB < split ? dstA + ((size_t)mB << 19) : dstB + ((size_t)(mB - split) << 19)) + (size_t)(ntB * 64) * ldd + ktB * 128;
#pragma unroll
            for (int j = 0; j < 8; ++j) { const int n2 = n0 + 8 * j; const int ng = ntB * 64 + n2; const float f = (ng >= sc_lo && ng < sc_hi) ? scale : 1.0f;
                *(unsigned*)(dB + (size_t)n2 * ldd + kp) = cvt_pk_bf16(tl[8320 + kp * 65 + n2] * f, tl[8320 + (kp + 1) * 65 + n2] * f); } }
        asm volatile("s_waitcnt lgkmcnt(0)" ::: "memory"); __builtin_amdgcn_s_barrier();
    }
}

__device__ __forceinline__ void cvt_run(const Cx& c, int j_lo, int j_hi, int p, int P, int glo, int ghi) {
    int off = 0;
#pragma unroll 1
    for (int j = j_lo; j < j_hi; ++j) {
        const int l = j >= 9 ? 1 : 0, k = j < 9 ? j : (j < 12 ? j - 3 : j - 12), set = (j >= 9 && j < 12) ? 1 : 0;
        const float* src; int ldsrc, K, N, ldd, nbatch = 1, sc_lo = 0, sc_hi = 0, mb = 0, split = 1; size_t sb = 0; bf16* dA; bf16* dB;
        if (k < 2) {
            src = c.in[8] + (size_t)l * 1024 * 4096 + k * 2048; ldsrc = 4096; K = 1024; N = 2048; ldd = 1024; dA = (bf16*)(c.ws + (k == 0 ? WS_WIN : WS_WG)); if (k == 0) { sc_lo = 512; sc_hi = 768; } }
        else if (k < 5) { src = c.in[k == 2 ? 17 : (k == 3 ? 18 : 23)] + (size_t)l * 512 * 1024; ldsrc = 1024; K = 512; N = 1024; ldd = 512; dA = (bf16*)(c.ws + WS_WA + (size_t)(k - 2) * 1024 * 512 * 2); }
        else if (k == 5) { src = c.in[24] + (size_t)l * 1024 * 1024; ldsrc = 1024; K = 1024; N = 1024; ldd = 1024; dA = (bf16*)(c.ws + WS_WOUT); }
        else { const int kind = k - 6; src = c.in[29 + kind] + (size_t)l * 16 * 1024 * 512; sb = (size_t)1024 * 512; nbatch = 16; mb = kind * 16;
            if (kind < 2) { ldsrc = 512; K = 1024; N = 512; ldd = 1024; } else { ldsrc = 1024; K = 512; N = 1024; ldd = 512; }
            const XW x = xw_set(c, set); dA = (bf16*)x.a; split = x.split; dB = (bf16*)x.b; }
        if (k < 6) dB = dA;
        cvt_T(c, p, P, src, ldsrc, sb, K, N, dA, dB, mb, split, ldd, nbatch, sc_lo, sc_hi, 0.125f, off, glo, ghi);
    }
}
__device__ __forceinline__ void cvt_w1(const Cx& c, int l, int p, int P) {
    const float* w1 = c.in[19] + (size_t)l * 2 * 1024 * 16;
    bf16* win = (bf16*)(c.ws + WS_WIN);
    for (int i = (p < 0 ? 2 * 16 * 512 : p * NTHR + c.tid); i < 2 * 16 * 512; i += P * NTHR) {
        const int kp = (i & 511) * 2, j = (i >> 9) & 15, d = i >> 13;
        const float* a0 = w1 + ((size_t)d * 1024 + kp) * 16 + j;
        *(unsigned*)(win + (size_t)(2048 + d * 16 + j) * 1024 + kp) = cvt_pk_bf16(a0[0], a0[16]);
    }
}
#ifndef BG_CFG
#define BG_CFG 3072, 3072, 3072, 3072, 3072, 3072
#endif
constexpr int BG_TAB[6] = {BG_CFG};
constexpr int BG_X0 = BG_TAB[0], BG_F = BG_TAB[1], BG_G = BG_TAB[2], BG_H = BG_TAB[3], BG_J = BG_TAB[4], BG_K = BG_TAB[5];
static_assert(BG_X0 <= BG_F && BG_F <= BG_G && BG_G <= BG_H && BG_H >= 3072 && BG_H <= BG_J && BG_J <= BG_K && BG_K <= 6144, "background slices");
__device__ __forceinline__ void ph_convert(PArgs pa) {
    const Cx c = make_cx(pa);
    cvt_run(c, 0, 9, c.vbid, c.vG, 0, 832 + BG_X0);
    cvt_w1(c, 0, c.vbid, c.vG);
}
__device__ __forceinline__ void ph_bg(PArgs pa, int nunits, int glo, int ghi, bool w1) {
    const Cx c = make_cx(pa);
    const int extra = nunits % c.G; const int p = extra ? c.bid - extra : c.bid, P = extra ? c.G - extra : c.G;
    __syncthreads();
    cvt_run(c, 6, 18, p, P, glo, ghi);
    if (w1) { cvt_run(c, 6, 18, p, P, 6144, 6976); cvt_w1(c, 1, p, P); }
}
__device__ __forceinline__ void ph_convert1(PArgs pa) {
    const Cx c = make_cx(pa);
    if (BG_K < 6144) cvt_run(c, 6, 12, c.vbid, c.vG, BG_K, 6144);
}

__device__ __forceinline__ void ph_s5prep(PArgs pa, int l, int p, int P, int u_lo, int u_hi) {
    const Cx c = make_cx(pa);
    float2* apow = (float2*)c.lds;
    float2* bbar = apow + 2 * 17 * 64;
    float2* cc = bbar + 2 * 64 * 16;
    float* KT = (float*)(cc + 2 * 16 * 64);
    double* kk = (double*)(KT + 2 * 16 * 256);
    for (int unit = p < 0 ? u_hi : u_lo + p; unit < u_hi; unit += P) {
        const int g = unit >> 3, s8 = unit & 7;
        float brv[4], biv[4], ccr[4], cci[4];
#pragma unroll
        for (int q = 0; q < 4; ++q) { const int i = c.tid + NTHR * q, dir = i >> 10; const size_t gi = ((size_t)(l * 2 + dir) * 32 + g);
            brv[q] = c.in[12][gi * 1024 + (i & 1023)]; biv[q] = c.in[13][gi * 1024 + (i & 1023)]; ccr[q] = c.in[14][gi * 1024 + (i & 1023)]; cci[q] = c.in[15][gi * 1024 + (i & 1023)]; }
        if (c.tid < 128) {
            const int dir = c.tid >> 6, p = c.tid & 63; const size_t gi = ((size_t)(l * 2 + dir) * 32 + g);
            const double lr = (double)c.in[9][gi * 64 + p], li = (double)c.in[10][gi * 64 + p], dt = my_exp((double)c.in[11][gi]);
            double sn, cs; my_sincos(li * dt, sn, cs); const double mag = my_exp(lr * dt);
            const double a1r = mag * cs, a1i = mag * sn;
            unsigned long long zz_ = 0; asm volatile("" : "+s"(zz_));
            double ar = __longlong_as_double(0x3FF0000000000000ull ^ zz_), ai = __longlong_as_double(zz_);
            for (int d = 0; d <= 16; ++d) {
                apow[(dir * 17 + d) * 64 + p] = make_float2((float)ar, (float)ai);
                if (d == 16 && s8 == 0) ((float2*)(c.ws + WS_S5AT))[(dir * 32 + g) * 64 + p] = make_float2((float)ar, (float)ai);
                const double nr = ar * a1r - ai * a1i, ni = ar * a1i + ai * a1r; ar = nr; ai = ni; }
            const double den = lr * lr + li * li, kr = ((a1r - 1.0) * lr + a1i * li) / den, ki = (a1i * lr - (a1r - 1.0) * li) / den;
            kk[c.tid * 2] = kr; kk[c.tid * 2 + 1] = ki;
        }
#pragma unroll
        for (int q = 0; q < 4; ++q) cc[c.tid + NTHR * q] = make_float2(ccr[q], cci[q]);
        __syncthreads();
#pragma unroll
        for (int q = 0; q < 4; ++q) { const int i = c.tid + NTHR * q; const double kr = kk[(i >> 4) * 2], ki = kk[(i >> 4) * 2 + 1], br = (double)brv[q], bi = (double)biv[q];
            bbar[i] = make_float2((float)(kr * br - ki * bi), (float)(kr * bi + ki * br)); }
        __syncthreads();
        for (int e2 = c.tid; e2 < 1024; e2 += NTHR) {
            const int dir = e2 >> 9, d = (e2 >> 5) & 15, ho = 2 * s8 + ((e2 >> 4) & 1), h = e2 & 15; float s = 0.f;
            for (int p = 0; p < 64; ++p) { const float2 cv = cc[(dir * 16 + ho) * 64 + p], av = apow[(dir * 17 + d) * 64 + p], bv = bbar[(dir * 64 + p) * 16 + h];
                const float gr = cv.x * av.x - cv.y * av.y, gim = cv.x * av.y + cv.y * av.x; s += gr * bv.x - gim * bv.y; }
            KT[(dir * 16 + d) * 256 + ho * 16 + h] = s;
        }
        __syncthreads();
        bf16* we = (bf16*)(c.ws + WS_WE) + (size_t)g * 256 * 256;
        for (int i = c.tid; i < 32 * 128; i += NTHR) {
            const int n = 32 * s8 + (i >> 7), k = (i & 127) * 2; const int dir = n >> 7, im = (n >> 6) & 1, p = n & 63, j = k >> 4, h = k & 15, d = dir == 0 ? 15 - j : j;
            const float2 av = apow[(dir * 17 + d) * 64 + p], b0 = bbar[(dir * 64 + p) * 16 + h], b1 = bbar[(dir * 64 + p) * 16 + h + 1];
            const float v0 = im ? (av.x * b0.y + av.y * b0.x) : (av.x * b0.x - av.y * b0.y), v1 = im ? (av.x * b1.y + av.y * b1.x) : (av.x * b1.x - av.y * b1.y);
            *(unsigned*)(we + (size_t)n * 256 + k) = cvt_pk_bf16(v0, v1);
        }
        bf16* wy = (bf16*)(c.ws + WS_WY) + (size_t)g * 256 * 512;
        const float* dsk = c.in[16] + (size_t)l * 512 + g * 16;
        for (int i = c.tid; i < 32 * 256; i += NTHR) {
            const int r = i >> 8, k = (i & 255) * 2; const int ii = r >> 1, ho = 2 * s8 + (r & 1), n = ii * 16 + ho; float v[2];
#pragma unroll
            for (int q = 0; q < 2; ++q) { const int kq = k + q; float s;
                if (kq < 256) { const int j = kq >> 4, h = kq & 15; s = 0.f;
                    if (j <= ii) s += KT[(0 * 16 + (ii - j)) * 256 + ho * 16 + h];
                    if (j >= ii) s += KT[(1 * 16 + (j - ii)) * 256 + ho * 16 + h];
                    if (j == ii && h == ho) s += dsk[ho]; }
                else { const int kk = kq - 256, which = kk >> 6, p = kk & 63, dir = which >> 1, d = dir == 0 ? ii + 1 : 16 - ii;
                    const float2 cv = cc[(dir * 16 + ho) * 64 + p], av = apow[(dir * 17 + d) * 64 + p];
                    s = (which & 1) ? -(cv.x * av.y + cv.y * av.x) : (cv.x * av.x - cv.y * av.y); }
                v[q] = s; }
            *(unsigned*)(wy + (size_t)n * 512 + k) = cvt_pk_bf16(v[0], v[1]);
        }
        __syncthreads();
    }
}

__device__ __forceinline__ void ph_norm(PArgs pa, int l, int which, int M) {
    const Cx c = make_cx(pa);
    const float* gw = (which == 0 ? c.in[6] : c.in[7]) + (size_t)l * D;
    bf16* H = HBUF(c); const bf16* latb = LATB(c);
    const bool srcf = (which == 0 && l == 0);
    int* lcnt = (int*)c.lds;
    int* gbase = lcnt + 32;
    int* erow = lcnt + 64; int* ebkt = erow + 192; int* elpos = ebkt + 192; float2* ew = (float2*)(elpos + 192);
    float4* wgl = (float4*)(c.lds + 8192);
    float4* wel = wgl + 1024;
    float* bl = (float*)(wel + 4096);
    float4* gwl = (float4*)(c.lds + 90368);
    float4* shl = gwl + 256;
    float4* scl = shl + 5 * 256;
    for (int i2 = c.tid; i2 < 11 * 256; i2 += NTHR) { const int t = i2 >> 8, col4 = i2 & 255, ln = col4 & 63, j = col4 >> 6;
        const float4 v = t == 0 ? ((const float4*)gw)[ln + 64 * j] : ((const float4*)mods_ptr(c, l, (t - 1) % 5, (t <= 5 ? (which == 0 ? 0 : 3) : (which == 0 ? 1 : 4))))[ln + 64 * j];
        (t == 0 ? gwl : (t <= 5 ? shl + (t - 1) * 256 : scl + (t - 6) * 256))[j * 64 + ln] = v; }
    if (which == 0) __syncthreads();
    if (which == 1) {
        if (c.tid < 64) lcnt[c.tid] = 0;
        const float4* g25 = (const float4*)(c.in[25] + (size_t)l * D * 4); const float4* g27 = (const float4*)(c.in[27] + (size_t)l * 4 * D * 4);
        for (int i = c.tid; i < 5 * 1024; i += NTHR) { const int t = i >> 10, col = i & 1023; const int ln = (col & 255) >> 2, j = col >> 8, q = col & 3;
            const float4 v = t == 0 ? g25[col] : g27[(size_t)(t - 1) * 1024 + col];
            (t == 0 ? wgl : wel + (t - 1) * 1024)[(j * 4 + q) * 64 + ln] = v; }
        if (c.tid < 4) bl[c.tid] = c.in[26][l * 4 + c.tid]; else if (c.tid < 20) bl[c.tid] = c.in[28][l * 16 + (c.tid - 4)];
        __syncthreads();
    }
    const int nw = (which == 0 ? c.vG : c.G) * 8, gwid = which == 0 ? (c.vbid < 0 ? M : c.vbid * 8 + c.wid) : c.bid * 8 + c.wid, lane = c.lane;
    auto proc = [&](const int r, const float4 (&v)[4]) {
        float ss = 0.f;
#pragma unroll
        for (int j = 0; j < 4; ++j) ss += v[j].x * v[j].x + v[j].y * v[j].y + v[j].z * v[j].z + v[j].w * v[j].w;
        ss = wave_sum(ss);
        const float rstd = rsqrtf(ss * (1.0f / 1024.0f) + 1e-6f);
        const int mi = mod_index(r);
        float hv[16];
#pragma unroll
        for (int j = 0; j < 4; ++j) { const int col = 4 * lane + 256 * j; const float4 g4 = gwl[j * 64 + lane], s4 = scl[mi * 256 + j * 64 + lane], h4 = shl[mi * 256 + j * 64 + lane];
            hv[4 * j + 0] = v[j].x * rstd * g4.x * (1.f + s4.x) + h4.x; hv[4 * j + 1] = v[j].y * rstd * g4.y * (1.f + s4.y) + h4.y;
            hv[4 * j + 2] = v[j].z * rstd * g4.z * (1.f + s4.z) + h4.z; hv[4 * j + 3] = v[j].w * rstd * g4.w * (1.f + s4.w) + h4.w;
            uint2 w; w.x = cvt_pk_bf16(hv[4 * j], hv[4 * j + 1]); w.y = cvt_pk_bf16(hv[4 * j + 2], hv[4 * j + 3]); *(uint2*)(H + (size_t)r * D + col) = w; }
        if (which == 1) {
            float gl[4] = {0.f, 0.f, 0.f, 0.f};
#pragma unroll
            for (int j = 0; j < 4; ++j)
#pragma unroll
                for (int q = 0; q < 4; ++q) { const float4 w4 = wgl[(j * 4 + q) * 64 + lane]; const float h = hv[4 * j + q];
                    gl[0] += h * w4.x; gl[1] += h * w4.y; gl[2] += h * w4.z; gl[3] += h * w4.w; }
#pragma unroll
            for (int q = 0; q < 4; ++q) gl[q] = wave_sum(gl[q]) + bl[q];
            int grp = 0; float gm = gl[0];
#pragma unroll
            for (int q = 1; q < 4; ++q) if (gl[q] > gm) { gm = gl[q]; grp = q; }
            float den = 0.f;
#pragma unroll
            for (int q = 0; q < 4; ++q) den += __expf(gl[q] - gm);
            const float pgrp = 1.0f / den;
            const float4* wre = wel + grp * 1024;
            float el[4] = {0.f, 0.f, 0.f, 0.f};
#pragma unroll
            for (int j = 0; j < 4; ++j)
#pragma unroll
                for (int q = 0; q < 4; ++q) { const float4 w4 = wre[(j * 4 + q) * 64 + lane]; const float h = hv[4 * j + q];
                    el[0] += h * w4.x; el[1] += h * w4.y; el[2] += h * w4.z; el[3] += h * w4.w; }
#pragma unroll
            for (int q = 0; q < 4; ++q) el[q] = wave_sum(el[q]) + bl[4 + grp * 4 + q];
            int ia = 0; float va = el[0];
#pragma unroll
            for (int q = 1; q < 4; ++q) if (el[q] > va) { va = el[q]; ia = q; }
            int ib = -1; float vb = -3.0e38f;
#pragma unroll
            for (int q = 0; q < 4; ++q) if (q != ia && el[q] > vb) { vb = el[q]; ib = q; }
            const float eb = __expf(vb - va), wa = pgrp / (1.0f + eb), wb = pgrp * eb / (1.0f + eb);
            const int lo = ia < ib ? ia : ib, hi = ia < ib ? ib : ia; const float wlo = ia < ib ? wa : wb, whi = ia < ib ? wb : wa;
            const int pair = lo == 0 ? hi - 1 : (lo == 1 ? hi + 1 : 5);
            const int bkt = grp * 6 + pair;
            if (lane == 0) { const int lp = atomicAdd(&lcnt[bkt], 1); const int e = atomicAdd(&lcnt[31], 1); erow[e] = r; ebkt[e] = bkt; elpos[e] = lp; ew[e] = make_float2(wlo, whi); }
        }
        };
    for (int r = gwid; r < M; r += 2 * nw) {
        const int r1 = r + nw; const bool has1 = r1 < M;
        const int r1c = has1 ? r1 : r;
        float4 v0[4], v1[4];
        if (srcf) {
            const float* src0 = in_row_f32(c, r); const float* src1 = in_row_f32(c, r1c);
#pragma unroll
            for (int j = 0; j < 4; ++j) v0[j] = *(const float4*)(src0 + 4 * lane + 256 * j);
#pragma unroll
            for (int j = 0; j < 4; ++j) v1[j] = *(const float4*)(src1 + 4 * lane + 256 * j);
        } else {
            uint2 w0[4], w1[4];
#pragma unroll
            for (int j = 0; j < 4; ++j) w0[j] = *(const uint2*)(latb + (size_t)r * D + 4 * lane + 256 * j);
#pragma unroll
            for (int j = 0; j < 4; ++j) w1[j] = *(const uint2*)(latb + (size_t)r1c * D + 4 * lane + 256 * j);
#pragma unroll
            for (int j = 0; j < 4; ++j) { v0[j] = make_float4(bflo(w0[j].x), bfhi(w0[j].x), bflo(w0[j].y), bfhi(w0[j].y)); v1[j] = make_float4(bflo(w1[j].x), bfhi(w1[j].x), bflo(w1[j].y), bfhi(w1[j].y)); }
        }
        proc(r, v0);
        if (has1) proc(r1, v1);
    }
    if (which == 1) {
        __syncthreads();
        unsigned* gcnt = (unsigned*)(c.ws + WS_CTL + CTL_CNT_OFF) + l * 32;
        if (c.tid < 24) gbase[c.tid] = (int)__hip_atomic_fetch_add(&gcnt[c.tid], (unsigned)lcnt[c.tid], __ATOMIC_RELAXED, __HIP_MEMORY_SCOPE_AGENT);
        __syncthreads();
        const int ne = lcnt[31];
        int* perm = (int*)(c.ws + WS_PERM); float2* pw = (float2*)(c.ws + WS_PW);
        for (int e = c.tid; e < ne; e += NTHR) { const int b = ebkt[e]; const size_t pos = (size_t)b * CAP + gbase[b] + elpos[e]; perm[pos] = erow[e]; pw[pos] = ew[e]; }
        __syncthreads();
    }
}

__device__ __forceinline__ void ph_final(PArgs pa) {
    const Cx c = make_cx(pa);
    const float* gw = c.in[32]; const bf16* latb = LATB(c);
    const int nw = c.G * 8, gwid = c.bid * 8 + c.wid, lane = c.lane;
    float4 g4[4];
#pragma unroll
    for (int j = 0; j < 4; ++j) g4[j] = *(const float4*)(gw + 4 * lane + 256 * j);
    for (int r = gwid; r < NLAT; r += 2 * nw) {
        const int r1 = r + nw; const bool has1 = r1 < NLAT; const int r1c = has1 ? r1 : r;
        uint2 w0[4], w1[4];
#pragma unroll
        for (int j = 0; j < 4; ++j) w0[j] = *(const uint2*)(latb + (size_t)r * D + 4 * lane + 256 * j);
#pragma unroll
        for (int j = 0; j < 4; ++j) w1[j] = *(const uint2*)(latb + (size_t)r1c * D + 4 * lane + 256 * j);
        float4 v0[4], v1[4]; float ss0 = 0.f, ss1 = 0.f;
#pragma unroll
        for (int j = 0; j < 4; ++j) { v0[j] = make_float4(bflo(w0[j].x), bfhi(w0[j].x), bflo(w0[j].y), bfhi(w0[j].y)); v1[j] = make_float4(bflo(w1[j].x), bfhi(w1[j].x), bflo(w1[j].y), bfhi(w1[j].y));
            ss0 += v0[j].x * v0[j].x + v0[j].y * v0[j].y + v0[j].z * v0[j].z + v0[j].w * v0[j].w; ss1 += v1[j].x * v1[j].x + v1[j].y * v1[j].y + v1[j].z * v1[j].z + v1[j].w * v1[j].w; }
        ss0 = wave_sum(ss0); ss1 = wave_sum(ss1);
        const float rs0 = rsqrtf(ss0 * (1.0f / 1024.0f) + 1e-6f), rs1 = rsqrtf(ss1 * (1.0f / 1024.0f) + 1e-6f);
        float* s0 = c.out + (size_t)r * D; float* s1 = c.out + (size_t)r1c * D;
#pragma unroll
        for (int j = 0; j < 4; ++j) { const int col = 4 * lane + 256 * j;
            float4 o; o.x = v0[j].x * rs0 * g4[j].x; o.y = v0[j].y * rs0 * g4[j].y; o.z = v0[j].z * rs0 * g4[j].z; o.w = v0[j].w * rs0 * g4[j].w; *(float4*)(s0 + col) = o; }
        if (has1) {
#pragma unroll
            for (int j = 0; j < 4; ++j) { const int col = 4 * lane + 256 * j;
                float4 o; o.x = v1[j].x * rs1 * g4[j].x; o.y = v1[j].y * rs1 * g4[j].y; o.z = v1[j].z * rs1 * g4[j].z; o.w = v1[j].w * rs1 * g4[j].w; *(float4*)(s1 + col) = o; }
        }
    }
}

__device__ __forceinline__ int gla_row(int b, int pc, int i) { return pc < 2 ? NLAT + b * 256 + pc * 128 + i : b * 8192 + i * 64 + (pc - 2); }
__device__ __forceinline__ size_t gla_state_idx(int b, int dir, int pc, int h) { return ((size_t)((b * 2 + dir) * NPC + pc) * 4 + h) * 8192; }

__device__ __forceinline__ void gla_deal(const Cx& c, int nunits, bool skew, int& u0, int& u1, int& step) {
    if (skew && c.G == 256 && nunits == 1056) { const int b = c.bid;
        if (b < 96) { u0 = 3 * b; u1 = u0 + 3; } else if (b < 192) { u0 = 288 + 4 * (b - 96); u1 = u0 + 4; } else { u0 = 672 + 6 * (b - 192); u1 = u0 + 6; }
        step = 1; }
    else { u0 = c.bid; u1 = nunits; step = c.G; }
}
struct GlaIn { uint4 q[2], k[2], v[4], t1; };
__device__ __forceinline__ void gla_kv_load(const bf16* proj, const bf16* t1b, int b, int pc, int h, int i, int part, GlaIn& r) {
    const int row = gla_row(b, pc, i);
    const bf16* rp = proj + (size_t)row * 2048;
    const uint4* p;
    p = (const uint4*)(rp + PQ + h * 64 + part * 16); r.q[0] = p[0]; r.q[1] = p[1];
    p = (const uint4*)(rp + PK + h * 64 + part * 16); r.k[0] = p[0]; r.k[1] = p[1];
    p = (const uint4*)(rp + PV + h * 128 + part * 32); r.v[0] = p[0]; r.v[1] = p[1]; r.v[2] = p[2]; r.v[3] = p[3];
    r.t1 = *(const uint4*)(t1b + (size_t)row * 32 + part * 8);
}
__device__ __forceinline__ void ph_gla_kv(PArgs pa, int l, bool skew) {
    const Cx c = make_cx(pa);
    constexpr int LAS_ = 68;
    float* LA = (float*)c.lds;
    float* tot = (float*)(c.lds + 69632);
    bf16* KTt = (bf16*)(c.lds + 73728);
    bf16* T1s = KTt;
    bf16* W2s = KTt + 2 * 128 * 40;
    bf16* VT = (bf16*)(c.lds + 73728 + 2 * 64 * 136 * 2);
    bf16* proj = (bf16*)(c.ws + WS_PROJ); const bf16* t1b = (const bf16*)(c.ws + WS_T1);
    bf16* kvb = (bf16*)(c.ws + WS_KVB); float* dec = (float*)(c.ws + WS_DEC);
    const float* w2g = c.in[20] + (size_t)l * 2 * 16 * 256; const float* bg = c.in[21] + (size_t)l * 2 * 256;
    const int lane = c.lane, fr = lane & 15, fq = lane >> 4;
    const int i = c.tid >> 2, part = c.tid & 3;
    const int nunits = 4 * NPC * 4;
    GlaIn in;
    int unit, uend, ustep; gla_deal(c, nunits, skew, unit, uend, ustep);
    float* bgl = (float*)(c.lds + 143360);
    bgl[c.tid] = bg[c.tid];
    const int d2_ = c.tid >> 8, ch_ = (c.tid >> 2) & 63, jq_ = c.tid & 3;
    float w2r[4] = {0.f, 0.f, 0.f, 0.f};
    if (unit < uend) { gla_kv_load(proj, t1b, unit / (4 * NPC), (unit >> 2) % NPC, unit & 3, i, part, in);
        const float* wp = w2g + ((size_t)d2_ * 16 + jq_ * 4) * 256 + (unit & 3) * 64 + ch_; w2r[0] = wp[0]; w2r[1] = wp[256]; w2r[2] = wp[512]; w2r[3] = wp[768]; }
    __syncthreads();
    for (; unit < uend; unit += ustep) {
        const int h = unit & 3, pc = (unit >> 2) % NPC, b = unit / (4 * NPC);
        const int row = gla_row(b, pc, i);
        const unsigned qw[8] = {in.q[0].x, in.q[0].y, in.q[0].z, in.q[0].w, in.q[1].x, in.q[1].y, in.q[1].z, in.q[1].w};
        const unsigned kw[8] = {in.k[0].x, in.k[0].y, in.k[0].z, in.k[0].w, in.k[1].x, in.k[1].y, in.k[1].z, in.k[1].w};
        {
            const int d = part >> 1, c0 = (part & 1) * 8;
            *(uint4*)(T1s + (d * 128 + i) * 40 + c0) = in.t1; *(uint4*)(T1s + (d * 128 + i) * 40 + 16 + c0) = make_uint4(0u, 0u, 0u, 0u);
            const int d2 = d2_, ch = ch_, jq = jq_;
            uint2 wv; wv.x = cvt_pk_bf16(w2r[0], w2r[1]); wv.y = cvt_pk_bf16(w2r[2], w2r[3]);
            *(uint2*)(W2s + (d2 * 64 + ch) * 40 + jq * 4) = wv; *(uint2*)(W2s + (d2 * 64 + ch) * 40 + 16 + jq * 4) = make_uint2(0u, 0u);
        }
        __syncthreads();
        {
            const float sc = 0.0625f * 1.4426950408889634f;
#pragma unroll
            for (int d = 0; d < 2; ++d) {
                const bf16x8 tf = *(const bf16x8*)(T1s + (d * 128 + c.wid * 16 + fr) * 40 + fq * 8);
#pragma unroll
                for (int n = 0; n < 4; ++n) {
                    const bf16x8 wf = *(const bf16x8*)(W2s + (d * 64 + n * 16 + fr) * 40 + fq * 8);
                    f32x4 z = (f32x4){0.f, 0.f, 0.f, 0.f};
                    z = __builtin_amdgcn_mfma_f32_16x16x32_bf16(wf, tf, z, 0, 0, 0);
                    const float4 b4 = *(const float4*)(bgl + d * 256 + h * 64 + n * 16 + fq * 4);
                    const float x0 = z[0] + b4.x, x1 = z[1] + b4.y, x2 = z[2] + b4.z, x3 = z[3] + b4.w;
                    float4 o;
                    o.x = (fminf(x0, 0.f) - __logf(1.0f + __expf(-fabsf(x0)))) * sc; o.y = (fminf(x1, 0.f) - __logf(1.0f + __expf(-fabsf(x1)))) * sc;
                    o.z = (fminf(x2, 0.f) - __logf(1.0f + __expf(-fabsf(x2)))) * sc; o.w = (fminf(x3, 0.f) - __logf(1.0f + __expf(-fabsf(x3)))) * sc;
                    *(float4*)(LA + (d * 128 + c.wid * 16 + fr) * LAS_ + n * 16 + fq * 4) = o;
                }
            }
        }
        {
            const uint4 vq[4] = {in.v[0], in.v[1], in.v[2], in.v[3]};
#pragma unroll
            for (int q = 0; q < 4; ++q) { const unsigned ww[4] = {vq[q].x, vq[q].y, vq[q].z, vq[q].w};
#pragma unroll
                for (int j = 0; j < 4; ++j) { const int vv = part * 32 + q * 8 + 2 * j, ix = i ^ (16 * part); VT[vv * 136 + ix] = (bf16)(ww[j] & 0xffffu); VT[(vv + 1) * 136 + ix] = (bf16)(ww[j] >> 16); } }
        }
        __syncthreads();
        {
            const int kk = c.tid & 63, seg = c.tid >> 6;
            float rf = 0.f, rb = 0.f;
#pragma unroll
            for (int j = 0; j < 16; ++j) { const int t0 = seg * 16 + j, t1 = seg * 16 + 15 - j; rf += LA[(0 * 128 + t0) * LAS_ + kk]; LA[(0 * 128 + t0) * LAS_ + kk] = rf; rb += LA[(1 * 128 + t1) * LAS_ + kk]; LA[(1 * 128 + t1) * LAS_ + kk] = rb; }
            tot[(0 * 8 + seg) * 64 + kk] = rf; tot[(1 * 8 + seg) * 64 + kk] = rb;
            __syncthreads();
            float of = 0.f, ob = 0.f;
#pragma unroll
            for (int s2 = 0; s2 < 8; ++s2) { const float tf = tot[(0 * 8 + s2) * 64 + kk], tb2 = tot[(1 * 8 + s2) * 64 + kk]; of += s2 < seg ? tf : 0.f; ob += s2 > seg ? tb2 : 0.f; }
#pragma unroll
            for (int j = 0; j < 16; ++j) { LA[(0 * 128 + seg * 16 + j) * LAS_ + kk] += of; LA[(1 * 128 + seg * 16 + j) * LAS_ + kk] += ob; }
            __syncthreads();
        }
        {
            bf16* rp = proj + (size_t)row * 2048;
            unsigned oqf[8], oqb[8], okf[8], okb[8];
#pragma unroll
            for (int j = 0; j < 8; ++j) {
                const int kk = part * 16 + 2 * j;
                const float2 bf2 = *(const float2*)(LA + (0 * 128 + i) * LAS_ + kk), bb2 = *(const float2*)(LA + (1 * 128 + i) * LAS_ + kk);
                const float2 ef2 = *(const float2*)(LA + (0 * 128 + 127) * LAS_ + kk), eb2 = *(const float2*)(LA + (1 * 128 + 0) * LAS_ + kk);
                const float q0 = bflo(qw[j]), q1 = bfhi(qw[j]), k0 = bflo(kw[j]), k1 = bfhi(kw[j]);
                oqf[j] = cvt_pk_bf16(q0 * __builtin_amdgcn_exp2f(bf2.x), q1 * __builtin_amdgcn_exp2f(bf2.y));
                oqb[j] = cvt_pk_bf16(q0 * __builtin_amdgcn_exp2f(bb2.x), q1 * __builtin_amdgcn_exp2f(bb2.y));
                okf[j] = cvt_pk_bf16(k0 * __builtin_amdgcn_exp2f(-bf2.x), k1 * __builtin_amdgcn_exp2f(-bf2.y));
                okb[j] = cvt_pk_bf16(k0 * __builtin_amdgcn_exp2f(-bb2.x), k1 * __builtin_amdgcn_exp2f(-bb2.y));
                const int ix = i ^ (16 * part);
                KTt[(0 * 64 + kk) * 136 + ix] = f2bf(k0 * __builtin_amdgcn_exp2f(ef2.x - bf2.x)); KTt[(0 * 64 + kk + 1) * 136 + ix] = f2bf(k1 * __builtin_amdgcn_exp2f(ef2.y - bf2.y));
                KTt[(1 * 64 + kk) * 136 + ix] = f2bf(k0 * __builtin_amdgcn_exp2f(eb2.x - bb2.x)); KTt[(1 * 64 + kk + 1) * 136 + ix] = f2bf(k1 * __builtin_amdgcn_exp2f(eb2.y - bb2.y));
            }
            uint4* o;
            o = (uint4*)(rp + PQ + h * 64 + part * 16); o[0] = make_uint4(oqf[0], oqf[1], oqf[2], oqf[3]); o[1] = make_uint4(oqf[4], oqf[5], oqf[6], oqf[7]);
            o = (uint4*)(rp + PK + h * 64 + part * 16); o[0] = make_uint4(oqb[0], oqb[1], oqb[2], oqb[3]); o[1] = make_uint4(oqb[4], oqb[5], oqb[6], oqb[7]);
            o = (uint4*)(rp + PZF + h * 64 + part * 16); o[0] = make_uint4(okf[0], okf[1], okf[2], okf[3]); o[1] = make_uint4(okf[4], okf[5], okf[6], okf[7]);
            o = (uint4*)(rp + PZB + h * 64 + part * 16); o[0] = make_uint4(okb[0], okb[1], okb[2], okb[3]); o[1] = make_uint4(okb[4], okb[5], okb[6], okb[7]);
            if (c.tid < 128) { const int d = c.tid >> 6, kk = c.tid & 63; dec[((size_t)((b * 2 + d) * NPC + pc) * 4 + h) * 64 + kk] = __builtin_amdgcn_exp2f(LA[(d * 128 + (d == 0 ? 127 : 0)) * LAS_ + kk]); }
        }
        { const int nu = unit + ustep; if (nu < uend) { gla_kv_load(proj, t1b, nu / (4 * NPC), (nu >> 2) % NPC, nu & 3, i, part, in);
            const float* wp = w2g + ((size_t)d2_ * 16 + jq_ * 4) * 256 + (nu & 3) * 64 + ch_; w2r[0] = wp[0]; w2r[1] = wp[256]; w2r[2] = wp[512]; w2r[3] = wp[768]; } }
        __syncthreads();
        f32x4 acc[2][4];
#pragma unroll
        for (int d = 0; d < 2; ++d)
#pragma unroll
            for (int n = 0; n < 4; ++n) acc[d][n] = (f32x4){0.f, 0.f, 0.f, 0.f};
#pragma unroll
        for (int ks = 0; ks < 4; ++ks) {
            const bf16x8 vf = *(const bf16x8*)(VT + (c.wid * 16 + fr) * 136 + ((ks * 32 + fq * 8) ^ (16 * (c.wid >> 1))));
#pragma unroll
            for (int d = 0; d < 2; ++d)
#pragma unroll
                for (int n = 0; n < 4; ++n) { const bf16x8 kf = *(const bf16x8*)(KTt + (d * 64 + n * 16 + fr) * 136 + ((ks * 32 + fq * 8) ^ (16 * n)));
                    acc[d][n] = __builtin_amdgcn_mfma_f32_16x16x32_bf16(kf, vf, acc[d][n], 0, 0, 0); }
        }
#pragma unroll
        for (int d = 0; d < 2; ++d)
#pragma unroll
            for (int n = 0; n < 4; ++n) store_bf16x4(kvb + gla_state_idx(b, d, pc, h) + (size_t)(c.wid * 16 + fr) * 64 + n * 16 + fq * 4, acc[d][n]);
        __syncthreads();
    }
}

__device__ __forceinline__ int s5_chain_br(int b, int dir, int j) {
    if (dir == 0) return j < 16 ? 2048 + b * 16 + j : b * 512 + (j - 16);
    return j < 16 ? 2048 + b * 16 + (15 - j) : b * 512 + (527 - j);
}
__device__ __forceinline__ void ph_scan(PArgs pa) {
    const Cx c = make_cx(pa);
    float2* segend = (float2*)c.lds;
    const bf16* eb = (const bf16*)(c.ws + WS_EB); bf16* usb = (bf16*)(c.ws + WS_USB);
    for (int unit = c.bid; unit < 256; unit += c.G) {
        const int b = unit >> 6, dir = (unit >> 5) & 1, g = unit & 31, p = c.tid & 63, seg = c.tid >> 6;
        const float2 aT = ((const float2*)(c.ws + WS_S5AT))[(dir * 32 + g) * 64 + p];
        float sr = 0.f, si = 0.f;
        const bf16* ebase = eb + (size_t)g * BRP * 256 + dir * 128 + p;
        float er[66], ei[66];
#pragma unroll
        for (int q = 0; q < 66; ++q) { const bf16* e = ebase + (size_t)s5_chain_br(b, dir, seg * 66 + q) * 256; er[q] = bf2f(e[0]); ei[q] = bf2f(e[64]); }
#pragma unroll
        for (int q = 0; q < 66; ++q) { const float nr = aT.x * sr - aT.y * si + er[q], ni = aT.x * si + aT.y * sr + ei[q]; sr = nr; si = ni; }
        segend[seg * 64 + p] = make_float2(sr, si);
        float pr = 1.f, pi = 0.f;
        for (int q = 0; q < 66; ++q) { const float nr = pr * aT.x - pi * aT.y, ni = pr * aT.y + pi * aT.x; pr = nr; pi = ni; }
        __syncthreads();
        sr = 0.f; si = 0.f;
        for (int s2 = 0; s2 < seg; ++s2) { const float2 e = segend[s2 * 64 + p]; const float nr = pr * sr - pi * si + e.x, ni = pr * si + pi * sr + e.y; sr = nr; si = ni; }
        bf16* obase = usb + (size_t)g * BRP * 512 + 256 + dir * 128 + p;
#pragma unroll
        for (int q = 0; q < 66; ++q) { bf16* o = obase + (size_t)s5_chain_br(b, dir, seg * 66 + q) * 512; o[0] = f2bf(sr); o[64] = f2bf(si);
            const float nr = aT.x * sr - aT.y * si + er[q], ni = aT.x * si + aT.y * sr + ei[q]; sr = nr; si = ni; }
        __syncthreads();
    }
    const unsigned* kvb = (const unsigned*)(c.ws + WS_KVB); unsigned* sst = (unsigned*)(c.ws + WS_SST); const float* dec = (const float*)(c.ws + WS_DEC);
    for (int e2 = c.bid * NTHR + c.tid; e2 < 4 * 2 * 4 * 4096; e2 += c.G * NTHR) {
        const int chain = e2 >> 12, within = (e2 & 4095) * 2, kk = within & 63; const int h = chain & 3, dir = (chain >> 2) & 1, b = chain >> 3;
        float s0 = 0.f, s1 = 0.f;
#pragma unroll 1
        for (int j0 = 0; j0 < NPC; j0 += 22) {
            unsigned kv[22]; float2 d2[22];
#pragma unroll
            for (int q = 0; q < 22; ++q) { const int j = j0 + q, pc = dir == 0 ? j : (j < 2 ? 1 - j : 67 - j);
                kv[q] = kvb[(gla_state_idx(b, dir, pc, h) + within) >> 1]; d2[q] = *(const float2*)(dec + ((size_t)((b * 2 + dir) * NPC + pc) * 4 + h) * 64 + kk); }
#pragma unroll
            for (int q = 0; q < 22; ++q) { const int j = j0 + q, pc = dir == 0 ? j : (j < 2 ? 1 - j : 67 - j);
                sst[(gla_state_idx(b, dir, pc, h) + within) >> 1] = cvt_pk_bf16(s0, s1); s0 = d2[q].x * s0 + bflo(kv[q]); s1 = d2[q].y * s1 + bfhi(kv[q]); }
        }
    }
}

typedef unsigned gu4 __attribute__((ext_vector_type(4)));
struct GlaOutIn { gu4 qf0, qf1, qb0, qb1, kf0, kf1, kb0, kb1, v0, v1, v2, v3; };
__device__ __forceinline__ void gla_out_load(const bf16* proj, int b, int pc, int h, int i, int part, GlaOutIn& r) {
    const bf16* rp = proj + (size_t)gla_row(b, pc, i) * 2048;
    const gu4* p;
    p = (const gu4*)(rp + PQ + h * 64 + part * 16); r.qf0 = p[0]; r.qf1 = p[1];
    p = (const gu4*)(rp + PK + h * 64 + part * 16); r.qb0 = p[0]; r.qb1 = p[1];
    p = (const gu4*)(rp + PZF + h * 64 + part * 16); r.kf0 = p[0]; r.kf1 = p[1];
    p = (const gu4*)(rp + PZB + h * 64 + part * 16); r.kb0 = p[0]; r.kb1 = p[1];
    p = (const gu4*)(rp + PV + h * 128 + part * 32); r.v0 = p[0]; r.v1 = p[1]; r.v2 = p[2]; r.v3 = p[3];
}
__device__ __forceinline__ void ph_gla_out(PArgs pa, int l, int pc_lo, bool skew) {
    const Cx c = make_cx(pa);
    bf16* P = (bf16*)c.lds;
    bf16* Q2 = (bf16*)(c.lds + 34816);
    bf16* KI = (bf16*)(c.lds + 69632);
    bf16* S2T = KI;
    bf16* VT = (bf16*)(c.lds + 106496);
    const bf16* proj = (const bf16*)(c.ws + WS_PROJ); const bf16* sst = (const bf16*)(c.ws + WS_SST); bf16* ob = (bf16*)(c.ws + WS_OB);
    const float* gn = c.in[22] + (size_t)l * 128;
    const int lane = c.lane, fr = lane & 15, fq = lane >> 4, w = c.wid;
    const int i = c.tid >> 2, part = c.tid & 3;
    const int npc = NPC - pc_lo, nunits = 4 * npc * 4;
    GlaOutIn in;
    int unit, uend, ustep; gla_deal(c, nunits, skew, unit, uend, ustep);
    float* gnl = (float*)(c.lds + 141312);
    if (c.tid < 128) gnl[c.tid] = gn[c.tid];
    if (unit < uend) gla_out_load(proj, unit / (4 * npc), pc_lo + (unit >> 2) % npc, unit & 3, i, part, in);
    for (; unit < uend; unit += ustep) {
        const int h = unit & 3, pc = pc_lo + (unit >> 2) % npc, b = unit / (4 * npc);
        typedef unsigned u4_t __attribute__((ext_vector_type(4)));
        const bf16* sp0 = sst + gla_state_idx(b, 0, pc, h) + (size_t)c.tid * 8; const bf16* sp1 = sst + gla_state_idx(b, 1, pc, h) + (size_t)c.tid * 8;
        const u4_t s00 = *(const u4_t*)(sp0), s01 = *(const u4_t*)(sp0 + 4096);
        const u4_t s10 = *(const u4_t*)(sp1), s11 = *(const u4_t*)(sp1 + 4096);
        const int orow = gla_row(b, pc, w * 16 + fr);
        typedef unsigned u2_t __attribute__((ext_vector_type(2)));
        u2_t rreg[8];
#pragma unroll
        for (int n = 0; n < 8; ++n) rreg[n] = *(const u2_t*)(proj + (size_t)orow * 2048 + PR + h * 128 + n * 16 + fq * 4);
        *(gu4*)(Q2 + i * 136 + part * 16) = in.qf0; *(gu4*)(Q2 + i * 136 + part * 16 + 8) = in.qf1;
        *(gu4*)(Q2 + i * 136 + 64 + part * 16) = in.qb0; *(gu4*)(Q2 + i * 136 + 64 + part * 16 + 8) = in.qb1;
        *(gu4*)(KI + (0 * 128 + i) * 72 + part * 16) = in.kf0; *(gu4*)(KI + (0 * 128 + i) * 72 + part * 16 + 8) = in.kf1;
        *(gu4*)(KI + (1 * 128 + i) * 72 + part * 16) = in.kb0; *(gu4*)(KI + (1 * 128 + i) * 72 + part * 16 + 8) = in.kb1;
        {
            const gu4 vq[4] = {in.v0, in.v1, in.v2, in.v3};
#pragma unroll
            for (int q = 0; q < 4; ++q) { const unsigned ww[4] = {vq[q].x, vq[q].y, vq[q].z, vq[q].w};
#pragma unroll
                for (int j = 0; j < 4; ++j) { const int vv = part * 32 + q * 8 + 2 * j, ix = i ^ (16 * part); VT[vv * 136 + ix] = (bf16)(ww[j] & 0xffffu); VT[(vv + 1) * 136 + ix] = (bf16)(ww[j] >> 16); } }
        }
        { const int nu = unit + ustep; if (nu < uend) gla_out_load(proj, nu / (4 * npc), pc_lo + (nu >> 2) % npc, nu & 3, i, part, in); }
        __syncthreads();
        {
            bf16x8 qf[2][2];
#pragma unroll
            for (int d = 0; d < 2; ++d)
#pragma unroll
                for (int ks = 0; ks < 2; ++ks) qf[d][ks] = *(const bf16x8*)(Q2 + (w * 16 + fr) * 136 + d * 64 + ks * 32 + fq * 8);
#pragma unroll 1
            for (int nt = 0; nt < 8; ++nt) {
                f32x4 pf = (f32x4){0.f, 0.f, 0.f, 0.f}, pb = (f32x4){0.f, 0.f, 0.f, 0.f};
                if (nt <= w) {
#pragma unroll
                    for (int ks = 0; ks < 2; ++ks) { const bf16x8 kf = *(const bf16x8*)(KI + (0 * 128 + nt * 16 + fr) * 72 + ks * 32 + fq * 8); pf = __builtin_amdgcn_mfma_f32_16x16x32_bf16(kf, qf[0][ks], pf, 0, 0, 0); } }
                if (nt >= w) {
#pragma unroll
                    for (int ks = 0; ks < 2; ++ks) { const bf16x8 kf = *(const bf16x8*)(KI + (1 * 128 + nt * 16 + fr) * 72 + ks * 32 + fq * 8); pb = __builtin_amdgcn_mfma_f32_16x16x32_bf16(kf, qf[1][ks], pb, 0, 0, 0); } }
                const int t = w * 16 + fr; f32x4 pv;
#pragma unroll
                for (int rg = 0; rg < 4; ++rg) { const int s2 = nt * 16 + fq * 4 + rg; pv[rg] = (s2 <= t ? pf[rg] : 0.f) + (s2 >= t ? pb[rg] : 0.f); }
                store_bf16x4(P + t * 136 + nt * 16 + fq * 4, pv);
            }
        }
        __syncthreads();
        { bf16* d0 = S2T + (c.tid >> 3) * 136 + (c.tid & 7) * 8;
          *(u4_t*)(d0) = s00; *(u4_t*)(d0 + 64 * 136) = s01;
          *(u4_t*)(d0 + 64) = s10; *(u4_t*)(d0 + 64 * 136 + 64) = s11; }
        __syncthreads();
        f32x4 acc[8];
#pragma unroll
        for (int n = 0; n < 8; ++n) acc[n] = (f32x4){0.f, 0.f, 0.f, 0.f};
#pragma unroll
        for (int ks = 0; ks < 4; ++ks) {
            const bf16x8 pa2 = *(const bf16x8*)(P + (w * 16 + fr) * 136 + ks * 32 + fq * 8);
#pragma unroll
            for (int n = 0; n < 8; ++n) { const bf16x8 vf = *(const bf16x8*)(VT + (n * 16 + fr) * 136 + ((ks * 32 + fq * 8) ^ (16 * (n >> 1)))); acc[n] = __builtin_amdgcn_mfma_f32_16x16x32_bf16(vf, pa2, acc[n], 0, 0, 0); }
        }
#pragma unroll
        for (int ks = 0; ks < 4; ++ks) {
            const bf16x8 qa = *(const bf16x8*)(Q2 + (w * 16 + fr) * 136 + ks * 32 + fq * 8);
#pragma unroll
            for (int n = 0; n < 8; ++n) { const bf16x8 sf = *(const bf16x8*)(S2T + (n * 16 + fr) * 136 + ks * 32 + fq * 8); acc[n] = __builtin_amdgcn_mfma_f32_16x16x32_bf16(sf, qa, acc[n], 0, 0, 0); }
        }
        float ss = 0.f;
#pragma unroll
        for (int n = 0; n < 8; ++n) ss += acc[n][0] * acc[n][0] + acc[n][1] * acc[n][1] + acc[n][2] * acc[n][2] + acc[n][3] * acc[n][3];
        ss += __shfl_xor(ss, 16); ss += __shfl_xor(ss, 32);
        const float rstd = rsqrtf(ss * (1.0f / 128.0f) + 1e-6f);
#pragma unroll
        for (int n = 0; n < 8; ++n) { const int vv = n * 16 + fq * 4; const float4 g4 = *(const float4*)(gnl + vv);
            const u2_t rw = rreg[n];
            f32x4 o; o[0] = acc[n][0] * rstd * g4.x * siluf_(bflo(rw.x)); o[1] = acc[n][1] * rstd * g4.y * siluf_(bfhi(rw.x));
            o[2] = acc[n][2] * rstd * g4.z * siluf_(bflo(rw.y)); o[3] = acc[n][3] * rstd * g4.w * siluf_(bfhi(rw.y));
            store_bf16x4(ob + (size_t)orow * 512 + h * 128 + vv, o); }
        __syncthreads();
    }
}

typedef unsigned u32x4 __attribute__((ext_vector_type(4)));
constexpr int LDS_MOE_TAB = 131072;
constexpr int LDS_EPI_TAB = 131072 + 2048;
__device__ __forceinline__ u32x4 pack8(const f32x4& a, const f32x4& b) { u32x4 w; w.x = cvt_pk_bf16(a[0], a[1]); w.y = cvt_pk_bf16(a[2], a[3]); w.z = cvt_pk_bf16(b[0], b[1]); w.w = cvt_pk_bf16(b[2], b[3]); return w; }

struct PlainSrc {
    const char* A; const char* B; int lda2, ldb2, nM, nN, G, c; unsigned inv;
    __device__ __forceinline__ bool next(int i, g8::GUnit& u) const {
        int pm, pn; if (!g8::tile_order(i * G + c, nM, nN, inv, pm, pn)) return false;
        u.pm = pm; u.pn = pn; u.x0 = 0; u.x1 = 0;
        u.A0 = A + (size_t)pm * 256 * lda2; u.A1 = u.A0 + (size_t)128 * lda2; u.B0 = B + (size_t)pn * 256 * ldb2; u.B1 = u.B0 + (size_t)128 * ldb2; u.cont = 0; return true; }
    __device__ __forceinline__ unsigned row_off(const g8::GUnit&, int) const { return 0u; }
    __device__ __forceinline__ void a_ready(const g8::GUnit&) const {}
    __device__ __forceinline__ void done(const g8::GUnit&) const {}
    __device__ __forceinline__ void prefetch(const g8::GUnit&, LAS unsigned char*, int, int) const {}
};
struct DualSrc {
    const char* A; const char* W0; const char* W1; int lda2, ldb2, nM, nN, G, c; unsigned inv;
    __device__ __forceinline__ bool next(int i, g8::GUnit& u) const {
        int pm, pn; if (!g8::tile_order(i * G + c, nM, nN, inv, pm, pn)) return false;
        u.pm = pm; u.pn = pn; u.x0 = 0; u.x1 = 0;
        u.A0 = A + (size_t)pm * 256 * lda2; u.A1 = u.A0 + (size_t)128 * lda2; u.B0 = W0 + (size_t)pn * 128 * ldb2; u.B1 = W1 + (size_t)pn * 128 * ldb2; u.cont = 0; return true; }
    __device__ __forceinline__ unsigned row_off(const g8::GUnit&, int) const { return 0u; }
    __device__ __forceinline__ void a_ready(const g8::GUnit&) const {}
    __device__ __forceinline__ void done(const g8::GUnit&) const {}
    __device__ __forceinline__ void prefetch(const g8::GUnit&, LAS unsigned char*, int, int) const {}
};
struct BatchSrc {
    const char* A; const char* W; int lda2, ldb2, nMg, G, c;
    __device__ __forceinline__ bool next(int i, g8::GUnit& u) const {
        int L = i * G + c;
        if (G == 256 && nMg == 9) {
            if (c < 96) L = i < 2 ? c + 96 * i : 288; else if (c < 192) L = i < 1 ? 96 + c : 288; else L = 288; }
        if (L >= 32 * nMg) return false;
        const int g = L / nMg, pm = L % nMg; u.pm = pm; u.pn = 0; u.x0 = g; u.x1 = 0;
        u.A0 = A + ((size_t)g * BRP + pm * 256) * lda2; u.A1 = u.A0 + (size_t)128 * lda2; u.B0 = W + (size_t)g * 256 * ldb2; u.B1 = u.B0 + (size_t)128 * ldb2; u.cont = 0; return true; }
    __device__ __forceinline__ unsigned row_off(const g8::GUnit&, int) const { return 0u; }
    __device__ __forceinline__ void a_ready(const g8::GUnit&) const {}
    __device__ __forceinline__ void done(const g8::GUnit&) const {}
    __device__ __forceinline__ void prefetch(const g8::GUnit&, LAS unsigned char*, int, int) const {}
};

struct EpiWin {
    static constexpr bool PERM = true;
    bf16* usb; bf16* proj; bf16* t1b; unsigned char* sg5q; unsigned char* sggq;
    __device__ __forceinline__ void operator()(const f32x4 (&acc)[2][2][4][2], const g8::GUnit& u, int wr, int wc, int fr, int fq) const {
        if (u.pn < 9) {
#pragma unroll
            for (int ai = 0; ai < 2; ++ai)
#pragma unroll
                for (int m = 0; m < 4; ++m) { const int row = u.pm * 256 + ai * 128 + wr * 64 + m * 16 + fr;
#pragma unroll
                    for (int bj = 0; bj < 2; ++bj) { const int col = u.pn * 256 + bj * 128 + wc * 32 + 8 * fq; const u32x4 w = pack8(acc[ai][bj][m][0], acc[ai][bj][m][1]);
                        if (col < 512) *(u32x4*)(usb + ((size_t)((col >> 4) * BRP + (row >> 4)) * 512 + (row & 15) * 16 + (col & 15))) = w;
                        else if (col < 2048) *(u32x4*)(proj + (size_t)row * 2048 + (col - 512)) = w;
                        else if (col < 2080) *(u32x4*)(t1b + (size_t)row * 32 + (col - 2048)) = w; } }
        } else {
            unsigned char* base = (u.pn < 13) ? sg5q : sggq; const int c0 = (u.pn - (u.pn < 13 ? 9 : 13)) * 256 + wc * 32 + 8 * fq;
#pragma unroll
            for (int ai = 0; ai < 2; ++ai)
#pragma unroll
                for (int m = 0; m < 4; ++m) { const int row = u.pm * 256 + ai * 128 + wr * 64 + m * 16 + fr;
#pragma unroll
                    for (int bj = 0; bj < 2; ++bj) { unsigned w[2];
#pragma unroll
                        for (int n = 0; n < 2; ++n) { unsigned q = 0;
#pragma unroll
                            for (int j = 0; j < 4; ++j) q |= (unsigned)__builtin_rintf(255.0f * sigmoidf_(acc[ai][bj][m][n][j])) << (8 * j);
                            w[n] = q; }
                        *(uint2*)(base + (size_t)row * 1024 + c0 + bj * 128) = make_uint2(w[0], w[1]); } }
        }
    }
};
struct EpiS5E {
    static constexpr bool PERM = true;
    bf16* eb;
    __device__ __forceinline__ void operator()(const f32x4 (&acc)[2][2][4][2], const g8::GUnit& u, int wr, int wc, int fr, int fq) const {
#pragma unroll
        for (int ai = 0; ai < 2; ++ai)
#pragma unroll
            for (int m = 0; m < 4; ++m) { const int row = u.pm * 256 + ai * 128 + wr * 64 + m * 16 + fr;
#pragma unroll
                for (int bj = 0; bj < 2; ++bj) { const int col = bj * 128 + wc * 32 + 8 * fq;
                    *(u32x4*)(eb + ((size_t)u.x0 * BRP + row) * 256 + col) = pack8(acc[ai][bj][m][0], acc[ai][bj][m][1]); } }
    }
};
struct EpiS5Y {
    static constexpr bool PERM = true;
    bf16* ab; int nbr;
    __device__ __forceinline__ void operator()(const f32x4 (&acc)[2][2][4][2], const g8::GUnit& u, int wr, int wc, int fr, int fq) const {
#pragma unroll
        for (int ai = 0; ai < 2; ++ai)
#pragma unroll
            for (int m = 0; m < 4; ++m) { const int row = u.pm * 256 + ai * 128 + wr * 64 + m * 16 + fr;
                if (row < nbr) {
#pragma unroll
                    for (int bj = 0; bj < 2; ++bj) { const int col = bj * 128 + wc * 32 + 8 * fq; f32x4 a = acc[ai][bj][m][0], b = acc[ai][bj][m][1];
#pragma unroll
                        for (int j = 0; j < 4; ++j) { a[j] = gelu_tanh(a[j]); b[j] = gelu_tanh(b[j]); }
                        *(u32x4*)(ab + ((size_t)row * 16 + (col >> 4)) * 512 + u.x0 * 16 + (col & 15)) = pack8(a, b); } } }
    }
};
struct EpiBf16 {
    static constexpr bool PERM = true;
    bf16* O; int ldo; int act;
    __device__ __forceinline__ void operator()(const f32x4 (&acc)[2][2][4][2], const g8::GUnit& u, int wr, int wc, int fr, int fq) const {
#pragma unroll
        for (int ai = 0; ai < 2; ++ai)
#pragma unroll
            for (int m = 0; m < 4; ++m) { const int row = u.pm * 256 + ai * 128 + wr * 64 + m * 16 + fr;
#pragma unroll
                for (int bj = 0; bj < 2; ++bj) { const int col = u.pn * 256 + bj * 128 + wc * 32 + 8 * fq; f32x4 a = acc[ai][bj][m][0], b = acc[ai][bj][m][1];
                    if (act) {
#pragma unroll
                        for (int j = 0; j < 4; ++j) { a[j] = sigmoidf_(a[j]); b[j] = sigmoidf_(b[j]); } }
                    *(u32x4*)(O + (size_t)row * ldo + col) = pack8(a, b); } }
    }
};
struct EpiMerge {
    static constexpr bool PERM = true;
    const unsigned char* sg5q; const unsigned char* sggq; const bf16* yg; bf16* mg;
    __device__ __forceinline__ void operator()(const f32x4 (&acc)[2][2][4][2], const g8::GUnit& u, int wr, int wc, int fr, int fq) const {
        const int col = u.pn * 128 + wc * 32 + 8 * fq; const int row00 = u.pm * 256 + wr * 64 + fr;
        const unsigned char* s5base = sg5q + (size_t)row00 * 1024 + col; const unsigned char* sgbase = sggq + (size_t)row00 * 1024 + col;
        const bf16* ybase = yg + (size_t)row00 * 1024 + col; bf16* mbase = mg + (size_t)row00 * 1024 + col;
        uint2 s5c = *(const uint2*)(s5base), sgc = *(const uint2*)(sgbase), s5n, sgn; u32x4 yc = *(const u32x4*)(ybase), yn;
        const float k = 1.0f / 255.0f;
#pragma unroll
        for (int gi = 0; gi < 8; ++gi) { const int ai = gi >> 2, m = gi & 3; const size_t ro = (size_t)(ai * 128 + m * 16);
            if (gi + 1 < 8) { const size_t rn = (size_t)(((gi + 1) >> 2) * 128 + ((gi + 1) & 3) * 16); s5n = *(const uint2*)(s5base + rn * 1024); sgn = *(const uint2*)(sgbase + rn * 1024); yn = *(const u32x4*)(ybase + rn * 1024); }
            f32x4 o0, o1;
#pragma unroll
            for (int j = 0; j < 4; ++j) {
                const float s50 = (float)((s5c.x >> (8 * j)) & 255u) * k, s51 = (float)((s5c.y >> (8 * j)) & 255u) * k, sg0 = (float)((sgc.x >> (8 * j)) & 255u) * k, sg1 = (float)((sgc.y >> (8 * j)) & 255u) * k;
                const float y0 = (j & 1) ? bfhi(yc[j >> 1]) : bflo(yc[j >> 1]), y1 = (j & 1) ? bfhi(yc[2 + (j >> 1)]) : bflo(yc[2 + (j >> 1)]);
                o0[j] = acc[ai][0][m][0][j] * sigmoidf_(acc[ai][1][m][0][j]) * s50 + sg0 * y0;
                o1[j] = acc[ai][0][m][1][j] * sigmoidf_(acc[ai][1][m][1][j]) * s51 + sg1 * y1; }
            *(u32x4*)(mbase + ro * 1024) = pack8(o0, o1);
            asm volatile("" ::: "memory");
            s5c = s5n; sgc = sgn; yc = yn; }
    }
};
struct EpiWout {
    static constexpr bool PERM = true;
    const float* x0; const float* x1; bf16* latb; const float* mods; int l;
    __device__ __forceinline__ void operator()(const f32x4 (&acc)[2][2][4][2], const g8::GUnit& u, int wr, int wc, int fr, int fq) const {
        const int row00 = u.pm * 256 + wr * 64 + fr; const int cbase = u.pn * 256 + wc * 32 + 8 * fq;
        const float* gp = mods + ((size_t)(l * 5 + mod_index(row00)) * 6144 + 2 * 1024) + cbase;
        f32x4 g4[2][2];
#pragma unroll
        for (int bj = 0; bj < 2; ++bj)
#pragma unroll
            for (int n = 0; n < 2; ++n) g4[bj][n] = *(const f32x4*)(gp + bj * 128 + 4 * n);
        bf16* obase = latb + (size_t)row00 * D + cbase;
        if (l == 0) {
            const float* ibase = (row00 < NLAT ? x0 + (size_t)row00 * D : x1 + (size_t)(row00 - NLAT) * D) + cbase;
            f32x4 xc[2][2], xn[2][2];
#pragma unroll
            for (int bj = 0; bj < 2; ++bj)
#pragma unroll
                for (int n = 0; n < 2; ++n) xc[bj][n] = *(const f32x4*)(ibase + bj * 128 + 4 * n);
#pragma unroll
            for (int gi = 0; gi < 8; ++gi) { const int ai = gi >> 2, m = gi & 3; const size_t roff = (size_t)(ai * 128 + m * 16) * D;
                if (gi + 1 < 8) { const size_t rn = (size_t)(((gi + 1) >> 2) * 128 + ((gi + 1) & 3) * 16) * D;
#pragma unroll
                    for (int bj = 0; bj < 2; ++bj)
#pragma unroll
                        for (int n = 0; n < 2; ++n) xn[bj][n] = *(const f32x4*)(ibase + rn + bj * 128 + 4 * n); }
#pragma unroll
                for (int bj = 0; bj < 2; ++bj) *(u32x4*)(obase + roff + bj * 128) = pack8(xc[bj][0] + g4[bj][0] * acc[ai][bj][m][0], xc[bj][1] + g4[bj][1] * acc[ai][bj][m][1]);
                asm volatile("" ::: "memory");
#pragma unroll
                for (int bj = 0; bj < 2; ++bj)
#pragma unroll
                    for (int n = 0; n < 2; ++n) xc[bj][n] = xn[bj][n]; }
        } else {
            u32x4 xc[2], xn[2];
#pragma unroll
            for (int bj = 0; bj < 2; ++bj) xc[bj] = *(const u32x4*)(obase + bj * 128);
#pragma unroll
            for (int gi = 0; gi < 8; ++gi) { const int ai = gi >> 2, m = gi & 3; const size_t roff = (size_t)(ai * 128 + m * 16) * D;
                if (gi + 1 < 8) { const size_t rn = (size_t)(((gi + 1) >> 2) * 128 + ((gi + 1) & 3) * 16) * D;
#pragma unroll
                    for (int bj = 0; bj < 2; ++bj) xn[bj] = *(const u32x4*)(obase + rn + bj * 128); }
#pragma unroll
                for (int bj = 0; bj < 2; ++bj) { const f32x4 a0 = (f32x4){bflo(xc[bj][0]), bfhi(xc[bj][0]), bflo(xc[bj][1]), bfhi(xc[bj][1])}, a1 = (f32x4){bflo(xc[bj][2]), bfhi(xc[bj][2]), bflo(xc[bj][3]), bfhi(xc[bj][3])};
                    *(u32x4*)(obase + roff + bj * 128) = pack8(a0 + g4[bj][0] * acc[ai][bj][m][0], a1 + g4[bj][1] * acc[ai][bj][m][1]); }
                asm volatile("" ::: "memory");
#pragma unroll
                for (int bj = 0; bj < 2; ++bj) xc[bj] = xn[bj]; }
        }
    }
};

struct Moe1Src {
    const char* H; XW xw; const int* perm; const LAS int* tb; int T, G, c; unsigned* ready; const float* pw;
    __device__ __forceinline__ bool next(int i, g8::GUnit& u) const {
        const int L = i * G + c; if (L >= T * 8) return false;
        const int Tm = T & ~7; int tau, sq; if (L < Tm * 8) { const int x = L & 7, idx = L >> 3; tau = (idx & ~7) + x; sq = idx & 7; } else { tau = L >> 3; sq = L & 7; }
        const int slot = sq >> 2, q = sq & 3; const int te = __builtin_amdgcn_readfirstlane(tb[64 + tau]); const int bk = te & 255;
        const int tloc = te >> 8, cnt = __builtin_amdgcn_readfirstlane(tb[32 + bk]); const int pair = bk % 6; const int lo = pair < 3 ? 0 : (pair < 5 ? 1 : 2), hi = pair < 3 ? pair + 1 : (pair < 5 ? pair - 1 : 3);
        const int e = (bk / 6) * 4 + (slot ? hi : lo);
        u.pm = tau; u.pn = q; u.x0 = bk | (slot << 8) | (tloc << 16); u.x1 = cnt;
        u.A0 = H; u.A1 = H; u.B0 = xw_ptr(xw, e) + (size_t)(q * 128) * 2048; u.B1 = xw_ptr(xw, 16 + e) + (size_t)(q * 128) * 2048; u.cont = 0; return true; }
    __device__ __forceinline__ unsigned row_off(const g8::GUnit& u, int r) const {
        const int bk = u.x0 & 255, tloc = u.x0 >> 16; int pos = tloc * 256 + r; pos = pos < u.x1 ? pos : u.x1 - 1;
        return (unsigned)perm[(size_t)bk * CAP + pos] * 2048u; }
    __device__ __forceinline__ void a_ready(const g8::GUnit&) const {}
    __device__ __forceinline__ void prefetch(const g8::GUnit& u, LAS unsigned char* lds, int wid, int lane) const {
        if (wid < 4) { const int bk = u.x0 & 255, slot = (u.x0 >> 8) & 1, tloc = u.x0 >> 16; int pos = tloc * 256 + wid * 64 + lane; pos = pos < u.x1 ? pos : u.x1 - 1;
            __builtin_amdgcn_global_load_lds((const unsigned*)(pw + ((size_t)bk * CAP + pos) * 2 + slot), (LAS unsigned*)(lds + LDS_EPI_TAB + u.par * 1024 + wid * 256), 4, 0, 0); }
    }
    __device__ __forceinline__ void done(const g8::GUnit& u) const {
        asm volatile("s_waitcnt vmcnt(0)" ::: "memory");
        if ((threadIdx.x & 63) == 0) __hip_atomic_fetch_add(ready + (size_t)u.pm * TILE_STRIDE, 1u, __ATOMIC_RELAXED, __HIP_MEMORY_SCOPE_AGENT);
    }
};
struct EpiMoe1 {
    static constexpr bool PERM = true;
    bf16* hid; const LAS float* wtab;
    __device__ __forceinline__ void operator()(const f32x4 (&acc)[2][2][4][2], const g8::GUnit& u, int wr, int wc, int fr, int fq) const {
        const int slot = (u.x0 >> 8) & 1;
        const __amdgpu_buffer_rsrc_t rs = __builtin_amdgcn_make_buffer_rsrc(hid, 0, TILE_CAP * 256 * 2048, 0x00020000);
        float wv[8];
#pragma unroll
        for (int gi = 0; gi < 8; ++gi) { const int r = (gi >> 2) * 128 + wr * 64 + (gi & 3) * 16 + fr; wv[gi] = wtab[u.par * 256 + r]; }
#pragma unroll
        for (int gi = 0; gi < 8; ++gi) { const int ai = gi >> 2, m = gi & 3; const int r = ai * 128 + wr * 64 + m * 16 + fr; f32x4 o0, o1;
#pragma unroll
            for (int j = 0; j < 4; ++j) { o0[j] = siluf_(acc[ai][0][m][0][j]) * acc[ai][1][m][0][j] * wv[gi]; o1[j] = siluf_(acc[ai][0][m][1][j]) * acc[ai][1][m][1][j] * wv[gi]; }
            __builtin_amdgcn_raw_buffer_store_b128(pack8(o0, o1), rs, (unsigned)((((size_t)u.pm * 256 + r) * 1024 + slot * 512 + u.pn * 128 + wc * 32 + 8 * fq) * 2), 0,   16); }
    }
};
struct Moe2Src {
    const char* hid; XW xw; const LAS int* tb; int T, G, c; const unsigned* ready; const int* perm;
    __device__ __forceinline__ bool next(int i, g8::GUnit& u) const {
        const int L = (i >> 1) * G + c, seg = i & 1; if (L >= T * 4) return false;
        const int Tm = T & ~7; int tau, pn; if (L < Tm * 4) { const int x = L & 7, idx = L >> 3; tau = (idx >> 2) * 8 + x; pn = idx & 3; } else { tau = L >> 2; pn = L & 3; }
        const int te = __builtin_amdgcn_readfirstlane(tb[64 + tau]); const int bk = te & 255;
        const int tloc = te >> 8, cnt = __builtin_amdgcn_readfirstlane(tb[32 + bk]); const int pair = bk % 6; const int lo = pair < 3 ? 0 : (pair < 5 ? 1 : 2), hi = pair < 3 ? pair + 1 : (pair < 5 ? pair - 1 : 3);
        const int e = (bk / 6) * 4 + (seg ? hi : lo);
        u.pm = tau; u.pn = pn; u.x0 = bk | (tloc << 16); u.x1 = cnt; u.cont = seg ? 0 : 1;
        u.A0 = hid + (size_t)tau * 256 * 2048 + seg * 1024; u.A1 = u.A0 + (size_t)128 * 2048;
        u.B0 = xw_ptr(xw, 32 + e) + (size_t)(pn * 256) * 1024; u.B1 = u.B0 + (size_t)128 * 1024; return true; }
    __device__ __forceinline__ unsigned row_off(const g8::GUnit&, int) const { return 0u; }
    __device__ __forceinline__ void a_ready(const g8::GUnit& u) const {
        if (u.cont) {
            if (threadIdx.x < 64) {
                unsigned spins = 0;
                while ((unsigned)__builtin_amdgcn_readfirstlane(__hip_atomic_load(ready + (size_t)u.pm * TILE_STRIDE, __ATOMIC_RELAXED, __HIP_MEMORY_SCOPE_AGENT)) < 64u) {
                    __builtin_amdgcn_s_sleep(2); if (++spins > (1u << 18)) break; }
                __builtin_amdgcn_fence(__ATOMIC_ACQUIRE, "agent");
                asm volatile("s_waitcnt vmcnt(0)" ::: "memory");
            }
            asm volatile("" ::: "memory"); __builtin_amdgcn_s_barrier(); asm volatile("" ::: "memory");
        }
    }
    __device__ __forceinline__ void done(const g8::GUnit&) const {}
    __device__ __forceinline__ void prefetch(const g8::GUnit& u, LAS unsigned char* lds, int wid, int lane) const {
        if (wid < 4) { const int bk = u.x0 & 255, tloc = u.x0 >> 16; int pos = tloc * 256 + wid * 64 + lane; pos = pos < u.x1 ? pos : u.x1 - 1;
            __builtin_amdgcn_global_load_lds((const unsigned*)(perm + (size_t)bk * CAP + pos), (LAS unsigned*)(lds + LDS_EPI_TAB + u.par * 1024 + wid * 256), 4, 0, 0); }
    }
};
struct EpiMoe2 {
    static constexpr bool PERM = true;
    bf16* latb; const float* mods; const LAS int* ttab; int l;
    __device__ __forceinline__ void operator()(const f32x4 (&acc)[2][2][4][2], const g8::GUnit& u, int wr, int wc, int fr, int fq) const {
        const int tloc = u.x0 >> 16, cnt = u.x1;
        const int cbase = u.pn * 256 + wc * 32 + 8 * fq;
        int tok[8];
#pragma unroll
        for (int gi = 0; gi < 8; ++gi) { const int r = (gi >> 2) * 128 + wr * 64 + (gi & 3) * 16 + fr; tok[gi] = ttab[u.par * 256 + r]; }
        u32x4 xc[2], xn[2]; f32x4 gc[2][2], gn2[2][2];
        { const int t0 = tok[0]; const bf16* op = latb + (size_t)t0 * D + cbase; const float* gp = mods + ((size_t)(l * 5 + mod_index(t0)) * 6144 + 5 * 1024) + cbase;
#pragma unroll
          for (int bj = 0; bj < 2; ++bj) { xc[bj] = *(const u32x4*)(op + bj * 128); gc[bj][0] = *(const f32x4*)(gp + bj * 128); gc[bj][1] = *(const f32x4*)(gp + bj * 128 + 4); } }
#pragma unroll
        for (int gi = 0; gi < 8; ++gi) { const int ai = gi >> 2, m = gi & 3; const int r = ai * 128 + wr * 64 + m * 16 + fr, pos = tloc * 256 + r;
            if (gi + 1 < 8) { const int t1 = tok[gi + 1]; const bf16* op = latb + (size_t)t1 * D + cbase; const float* gp = mods + ((size_t)(l * 5 + mod_index(t1)) * 6144 + 5 * 1024) + cbase;
#pragma unroll
                for (int bj = 0; bj < 2; ++bj) { xn[bj] = *(const u32x4*)(op + bj * 128); gn2[bj][0] = *(const f32x4*)(gp + bj * 128); gn2[bj][1] = *(const f32x4*)(gp + bj * 128 + 4); } }
            if (pos < cnt) { bf16* op = latb + (size_t)tok[gi] * D + cbase;
#pragma unroll
                for (int bj = 0; bj < 2; ++bj) { const f32x4 a0 = (f32x4){bflo(xc[bj][0]), bfhi(xc[bj][0]), bflo(xc[bj][1]), bfhi(xc[bj][1])}, a1 = (f32x4){bflo(xc[bj][2]), bfhi(xc[bj][2]), bflo(xc[bj][3]), bfhi(xc[bj][3])};
                    *(u32x4*)(op + bj * 128) = pack8(a0 + gc[bj][0] * acc[ai][bj][m][0], a1 + gc[bj][1] * acc[ai][bj][m][1]); } }
            asm volatile("" ::: "memory");
#pragma unroll
            for (int bj = 0; bj < 2; ++bj) { xc[bj] = xn[bj]; gc[bj][0] = gn2[bj][0]; gc[bj][1] = gn2[bj][1]; } }
    }
};

__device__ __forceinline__ void fph_win(PArgs pa) {
    const Cx c = make_cx(pa);
    PlainSrc S{(const char*)HBUF(c), (const char*)(c.ws + WS_WIN), 2048, 2048, MTOT / 256, (NWIN + 2048) / 256, c.G, c.bid, g8::nig_inv((NWIN + 2048) / 256)};
    EpiWin E{(bf16*)(c.ws + WS_USB), (bf16*)(c.ws + WS_PROJ), (bf16*)(c.ws + WS_T1), (unsigned char*)(c.ws + WS_SG5Q), SGGQ(c)};
    g8::gemm256<EpiWin, PlainSrc, false>(pa.lds, S, E, 16, 1024, 1024);
}
__device__ __forceinline__ void fph_s5_e(PArgs pa) {
    const Cx c = make_cx(pa);
    BatchSrc S{(const char*)(c.ws + WS_USB), (const char*)(c.ws + WS_WE), 1024, 512, 9, c.G, c.bid};
    EpiS5E E{(bf16*)(c.ws + WS_EB)};
    g8::gemm256<EpiS5E, BatchSrc, false>(pa.lds, S, E, 4, 512, 256);
}
__device__ __forceinline__ void fph_s5_y(PArgs pa, int nbr) {
    const Cx c = make_cx(pa);
    BatchSrc S{(const char*)(c.ws + WS_USB), (const char*)(c.ws + WS_WY), 1024, 1024, (nbr + 255) / 256, c.G, c.bid};
    EpiS5Y E{(bf16*)(c.ws + WS_AB), nbr};
    g8::gemm256<EpiS5Y, BatchSrc, false>(pa.lds, S, E, 8, 512, 512);
}
__device__ __forceinline__ void fph_gates(PArgs pa, int M) {
    const Cx c = make_cx(pa);
    PlainSrc S{(const char*)(c.ws + WS_OB), (const char*)(c.ws + WS_WUP), 1024, 1024, M / 256, 4, c.G, c.bid, g8::nig_inv(4)};
    EpiBf16 E{(bf16*)(c.ws + WS_USB), 1024, 0};
    g8::gemm256<EpiBf16, PlainSrc, false>(pa.lds, S, E, 8, 512, 512);
}
__device__ __forceinline__ void fph_merge(PArgs pa, int M) {
    const Cx c = make_cx(pa);
    DualSrc S{(const char*)(c.ws + WS_AB), (const char*)(c.ws + WS_WA), (const char*)(c.ws + WS_WB), 1024, 1024, M / 256, 8, c.G, c.bid, g8::nig_inv(8)};
    EpiMerge E{(const unsigned char*)(c.ws + WS_SG5Q), SGGQ(c), (const bf16*)(c.ws + WS_USB), (bf16*)(c.ws + WS_PROJ)};
    g8::gemm256<EpiMerge, DualSrc, false>(pa.lds, S, E, 8, 512, 512);
}
__device__ __forceinline__ void fph_wout(PArgs pa, int l, int M) {
    const Cx c = make_cx(pa);
    PlainSrc S{(const char*)(c.ws + WS_PROJ), (const char*)(c.ws + WS_WOUT), 2048, 2048, M / 256, 4, c.G, c.bid, g8::nig_inv(4)};
    EpiWout E{c.in[0], c.in[2], LATB(c), (const float*)(c.ws + WS_MODS), l};
    g8::gemm256<EpiWout, PlainSrc, false>(pa.lds, S, E, 16, 1024, 1024);
}
__device__ __forceinline__ void moe_tiles_fast(const Cx& c, int l, LAS int* tb) {
    const unsigned* gcnt = (const unsigned*)(c.ws + WS_CTL + CTL_CNT_OFF) + l * 32;
    if (c.tid == 0) { int s = 0; for (int b = 0; b < 24; ++b) { tb[b] = s; const int cnt = (int)gcnt[b]; tb[32 + b] = cnt; s += (cnt + 255) / 256; } tb[24] = s; }
    __syncthreads();
    if (c.tid < tb[24]) { int bk = 0, tbase = 0, prev = tb[0]; for (int b = 0; b < 24; ++b) { const int nb = tb[b + 1]; if (prev <= c.tid && c.tid < nb) { bk = b; tbase = prev; } prev = nb; }
        tb[64 + c.tid] = bk | ((c.tid - tbase) << 8); }
    __syncthreads();
}
__device__ __forceinline__ void fph_moe(PArgs pa, int l) {
    const Cx c = make_cx(pa);
    LAS int* tb = (LAS int*)(pa.lds + LDS_MOE_TAB); moe_tiles_fast(c, l, tb);
    const int T = __builtin_amdgcn_readfirstlane(tb[24]);
    unsigned* ready = (unsigned*)(c.ws + WS_CTL + CTL_TILE_OFF) + (size_t)l * TILE_CAP * TILE_STRIDE;
    {
        Moe1Src S{(const char*)HBUF(c), xw_set(c, l), (const int*)(c.ws + WS_PERM), tb, T, c.G, c.bid, ready, (const float*)(c.ws + WS_PW)};
        EpiMoe1 E{(bf16*)(c.ws + WS_PROJ), (const LAS float*)(pa.lds + LDS_EPI_TAB)};
        g8::gemm256<EpiMoe1, Moe1Src, true>(pa.lds, S, E, 16, 1024, 1024);
    }
    __syncthreads();
    {
        const int k0 = ((c.bid - (T * 8) % c.G) % c.G + c.G) % c.G;
        Moe2Src S{(const char*)(c.ws + WS_PROJ), xw_set(c, l), tb, T, c.G, k0, ready, (const int*)(c.ws + WS_PERM)};
        EpiMoe2 E{LATB(c), (const float*)(c.ws + WS_MODS), (const LAS int*)(pa.lds + LDS_EPI_TAB), l};
        g8::gemm256<EpiMoe2, Moe2Src, false>(pa.lds, S, E, 8, 1024, 512);
    }
    __syncthreads();
    if (l == 0) ph_bg(pa, T * 12, BG_H, BG_K, true);
}

extern "C" __global__ void __launch_bounds__(NTHR, 2) mk_fwd(Args args) {
    extern __shared__ __attribute__((aligned(16))) unsigned char lds_raw[];
    PArgs pa; pa.out = args.out; pa.ws = args.ws; pa.lds = (LAS unsigned char*)lds_raw;
    volatile LAS unsigned* bst = (volatile LAS unsigned*)(lds_raw + LDS_BYTES - 16);
    if (threadIdx.x == 0) { bst[0] = 0u; bst[1] = 0u; bst[2] = 0u; bst[3] = 0u; }
    if (threadIdx.x < 33) ((LAS long long*)(lds_raw + LDS_TAB_OFF))[threadIdx.x] = (long long)((const char*)args.in[threadIdx.x] - (const char*)args.ws);
    __syncthreads();
    const int lo = args.ph_lo, hi = args.ph_hi;
    XcdBarrier bar; bar.bar = (unsigned*)(args.ws + WS_CTL); bar.x = 0; bar.st = bst;
    if (hi - lo > 1) bar = xcd_barrier_post((unsigned*)(args.ws + WS_CTL), bst);
#ifndef MK_ONLY
#define MK_ONLY -1
#endif
#define IN(k) ((MK_ONLY < 0 || ((k) == 0 ? 0 : ((k) == 23 ? 12 : ((k) - 1) % 11 + 1)) == MK_ONLY) && lo <= (k) && (k) < hi)
#define SEAM(k) do { if (IN((k) + 1)) xcd_barrier(bar); } while (0)
    if (IN(0)) { ph_mods(pa); __syncthreads(); ph_convert(pa); __syncthreads(); ph_s5prep(pa, 0, (int)blockIdx.x, (int)gridDim.x, 0, 256); SEAM(0); }
#define LAYER_BODY(l) { \
        const int base = 1 + 11 * (l); \
        const int M = (l == 0) ? MTOT : NLAT; \
        if (IN(base + 0)) { if (l != 0) { ph_convert1(pa); __syncthreads(); } ph_norm(pa, l, 0, MTOT); SEAM(base + 0); } \
        if (IN(base + 1)) { fph_win(pa); SEAM(base + 1); } \
        if (IN(base + 2)) { fph_s5_e(pa); __syncthreads(); ph_gla_kv(pa, l, true); SEAM(base + 2); } \
        if (IN(base + 3)) { ph_scan(pa); SEAM(base + 3); } \
        if (IN(base + 4)) { fph_s5_y(pa, l == 0 ? NBR : 2048); __syncthreads(); ph_gla_out(pa, l, l == 0 ? 0 : 2, l == 0); SEAM(base + 4); } \
        if (IN(base + 5)) { fph_gates(pa, M); if (l == 0) { ph_bg(pa, (M / 256) * 4, BG_X0, BG_F, false); const int ex_ = ((M / 256) * 4) % (int)gridDim.x, P_ = (int)gridDim.x - ex_; ph_s5prep(pa, 1, (int)blockIdx.x - ex_, P_, 0, P_ < 256 ? P_ : 256); } SEAM(base + 5); } \
        if (IN(base + 6)) { fph_merge(pa, M); if (l == 0) { ph_bg(pa, (M / 256) * 8, BG_F, BG_G, false); const int exF_ = ((M / 256) * 4) % (int)gridDim.x, PF_ = (int)gridDim.x - exF_, ex_ = ((M / 256) * 8) % (int)gridDim.x, P_ = (int)gridDim.x - ex_; ph_s5prep(pa, 1, (int)blockIdx.x - ex_, P_, PF_ < 256 ? PF_ : 256, 256); } SEAM(base + 6); } \
        if (IN(base + 7)) { fph_wout(pa, l, M); if (l == 0) ph_bg(pa, (M / 256) * 4, BG_G, BG_H, false); SEAM(base + 7); } \
        if (IN(base + 8)) { ph_norm(pa, l, 1, M); SEAM(base + 8); } \
        if (IN(base + 9)) { fph_moe(pa, l); SEAM(base + 9); } \
    }
#pragma unroll 1
    for (int l = 0; l < 2; ++l) {
        PArgs pa0 = pa; { unsigned long long z0 = 0, z1 = 0; unsigned z2 = 0; asm volatile("" : "+s"(z0), "+s"(z1), "+s"(z2)); pa0.out = pa.out + z0; pa0.ws = pa.ws + z1; pa0.lds = pa.lds + z2; }
        const PArgs pa = pa0;
        LAYER_BODY(l)
    }
#undef LAYER_BODY
    if (IN(23)) ph_final(pa);
#undef IN
#undef SEAM
}

}

extern "C" void kernel_launch(void* const* d_in, const int* in_sizes, int n_in, void* d_out, int out_size, void* d_ws, size_t ws_size, hipStream_t stream) {
    static int grid = 0;
    if (grid == 0) {
        if (n_in != 33 || out_size != NLAT * D || ws_size < WS_END) { fprintf(stderr, "kernel_launch: unexpected shapes (n_in %d out %d ws %zu need %zu)\n", n_in, out_size, ws_size, (size_t)WS_END); grid = -1; return; }
        int dev = 0, cus = 0, per_cu = 0;
        if (hipGetDevice(&dev) != hipSuccess || hipDeviceGetAttribute(&cus, hipDeviceAttributeMultiprocessorCount, dev) != hipSuccess) { grid = -1; return; }
        if (hipFuncSetAttribute((const void*)mk_fwd, hipFuncAttributeMaxDynamicSharedMemorySize, LDS_BYTES) != hipSuccess) { fprintf(stderr, "kernel_launch: hipFuncSetAttribute failed\n"); grid = -1; return; }
        if (hipOccupancyMaxActiveBlocksPerMultiprocessor(&per_cu, (const void*)mk_fwd, NTHR, LDS_BYTES) != hipSuccess || per_cu < 1) { fprintf(stderr, "kernel_launch: occupancy query says %d\n", per_cu); }
        (void)hipGetLastError();
        grid = cus;
    }
    if (grid < 0) return;
    (void)hipMemsetAsync((char*)d_ws + WS_CTL, 0, CTL_BYTES, stream);
    Args a{};
    for (int i = 0; i < 33; ++i) a.in[i] = (const float*)d_in[i];
    a.out = (float*)d_out; a.ws = (unsigned char*)d_ws;
#if MK_ONE_LAUNCH
    a.ph_lo = 0; a.ph_hi = NPHASE;
    hipLaunchKernelGGL(mk_fwd, dim3(grid), dim3(NTHR), LDS_BYTES, stream, a);
#else
    for (int p = 0; p < NPHASE; ++p) { a.ph_lo = p; a.ph_hi = p + 1; hipLaunchKernelGGL(mk_fwd, dim3(grid), dim3(NTHR), LDS_BYTES, stream, a); }
#endif
}
```
